# Optimizing an MI355X kernel written in HIP

```python
import jax, jax.numpy as jnp
from jax import lax
import numpy as np

D_MODEL = 2048
BATCH = 2
SEQ = 8192
DEPTH = 4

GRID_W = 64
CTX_LEN = 256
N_MIXERS = 3
EXPAND = 2
D_BRANCH = EXPAND * D_MODEL
FNET_GROUPS = 16
FNET_GROUP_DIM = D_BRANCH // FNET_GROUPS
ATTN_HEAD_DIM = 64
ATTN_Q_HEADS = D_BRANCH // ATTN_HEAD_DIM
ATTN_KV_HEADS = 8
ATTN_GROUP = ATTN_Q_HEADS // ATTN_KV_HEADS
WINDOW = 128
ATTN_BLOCK = 128
ROPE_BASE = 10000.0
GMLP_CHUNK = 128
GMLP_GROUPS = 16
GMLP_GROUP_DIM = D_BRANCH // GMLP_GROUPS
EPS = 1e-6
NEG_INF = -1e30

kernel_name = 'hybrid_fnet_swa_gmlp_prefix_dit'


def _rmsnorm(x, g):
    x32 = x.astype(jnp.float32)
    y = x32 * lax.rsqrt(jnp.mean(x32 * x32, axis=-1, keepdims=True) + EPS)
    return (y * g.astype(jnp.float32)).astype(x.dtype)


def _layernorm(x, g, b):
    x32 = x.astype(jnp.float32)
    mu = jnp.mean(x32, axis=-1, keepdims=True)
    var = jnp.mean(jnp.square(x32 - mu), axis=-1, keepdims=True)
    y = (x32 - mu) * lax.rsqrt(var + EPS)
    return (y * g.astype(jnp.float32) + b.astype(jnp.float32)).astype(x.dtype)


def _rope_half(xp, pos):
    nf = xp.shape[-1] // 2
    inv = ROPE_BASE ** (-jnp.arange(nf, dtype=jnp.float32) / nf)
    ang = pos[:, None] * inv[None, :]
    cos = jnp.cos(ang)[None, :, None, :]
    sin = jnp.sin(ang)[None, :, None, :]
    x1, x2 = xp[..., :nf], xp[..., nf:]
    return jnp.concatenate([x1 * cos - x2 * sin, x1 * sin + x2 * cos], axis=-1)


def _axial_rope(x, rows, cols):
    half = x.shape[-1] // 2
    x32 = x.astype(jnp.float32)
    out = jnp.concatenate([_rope_half(x32[..., :half], rows), _rope_half(x32[..., half:], cols)], axis=-1)
    return out.astype(x.dtype)


def _fourier_branch(h, w_in, w_mix):
    b, n, _ = h.shape
    u, z = jnp.split(h @ w_in, 2, axis=-1)
    ug = u.reshape(b, n, FNET_GROUPS, FNET_GROUP_DIM).astype(jnp.float32)
    f = jnp.fft.fft2(ug, axes=(1, 3), norm='ortho').real.astype(h.dtype)
    f = jnp.einsum('bngc,gcd->bngd', f, w_mix).reshape(b, n, D_BRANCH)
    return f * jax.nn.silu(z)


def _gmlp_branch(h, w_in, w_s, b_s, ln_g, ln_b):
    b, n, _ = h.shape
    uv, z = jnp.split(h @ w_in, [2 * D_BRANCH], axis=-1)
    u, v = jnp.split(jax.nn.gelu(uv), 2, axis=-1)
    v = _layernorm(v, ln_g, ln_b)
    vc = v.reshape(b, n // GMLP_CHUNK, GMLP_CHUNK, GMLP_GROUPS, GMLP_GROUP_DIM)
    s = jnp.einsum('gst,bktgc->bksgc', w_s, vc) + b_s.T[:, :, None]
    return u * s.reshape(b, n, D_BRANCH) * jax.nn.silu(z)


def _attend_with_sink(q, k, v, sink, mask=None):
    s = jnp.einsum('bqhgd,bkhd->bhgqk', q, k).astype(jnp.float32) * (ATTN_HEAD_DIM ** -0.5)
    if mask is not None:
        s = jnp.where(mask, s, NEG_INF)
    sk = jnp.broadcast_to(sink.astype(jnp.float32)[None, :, :, None, None], s.shape[:-1] + (1,))
    p = jax.nn.softmax(jnp.concatenate([s, sk], axis=-1), axis=-1)[..., :-1]
    return jnp.einsum('bhgqk,bkhd->bqhgd', p.astype(v.dtype), v)


def _attention_branch(h, hc, w_in, sink, rows, cols, need_ctx):
    b, n, _ = h.shape
    lc = hc.shape[1]
    kvw = ATTN_KV_HEADS * ATTN_HEAD_DIM
    q, k, v, z = jnp.split(h @ w_in, [D_BRANCH, D_BRANCH + kvw, D_BRANCH + 2 * kvw], axis=-1)
    kc, vc = jnp.split(hc @ w_in[:, D_BRANCH:D_BRANCH + 2 * kvw], 2, axis=-1)
    kc = kc.reshape(b, lc, ATTN_KV_HEADS, ATTN_HEAD_DIM)
    vc = vc.reshape(b, lc, ATTN_KV_HEADS, ATTN_HEAD_DIM)
    sink = sink.reshape(ATTN_KV_HEADS, ATTN_GROUP)
    q = _axial_rope(q.reshape(b, n, ATTN_Q_HEADS, ATTN_HEAD_DIM), rows, cols)
    k = _axial_rope(k.reshape(b, n, ATTN_KV_HEADS, ATTN_HEAD_DIM), rows, cols)
    v = v.reshape(b, n, ATTN_KV_HEADS, ATTN_HEAD_DIM)
    nb = n // ATTN_BLOCK
    qb = q.reshape(b, nb, ATTN_BLOCK, ATTN_KV_HEADS, ATTN_GROUP, ATTN_HEAD_DIM)

    def band(t):
        tp = jnp.pad(t, ((0, 0), (ATTN_BLOCK, ATTN_BLOCK), (0, 0), (0, 0)))
        tp = tp.reshape(b, nb + 2, ATTN_BLOCK, ATTN_KV_HEADS, ATTN_HEAD_DIM)
        return jnp.concatenate([tp[:, :-2], tp[:, 1:-1], tp[:, 2:]], axis=2)

    kw, vw = band(k), band(v)
    q_off = jnp.arange(ATTN_BLOCK)
    k_off = jnp.arange(3 * ATTN_BLOCK) - ATTN_BLOCK
    ctx_mask = jnp.ones((ATTN_BLOCK, lc), dtype=bool)

    def block(args):
        qi, ki, vi, blk = args
        qpos = blk * ATTN_BLOCK + q_off
        kpos = blk * ATTN_BLOCK + k_off
        valid = (jnp.abs(qpos[:, None] - kpos[None, :]) <= WINDOW) & ((kpos >= 0) & (kpos < n))[None, :]
        mask = jnp.concatenate([valid, ctx_mask], axis=1)
        keys = jnp.concatenate([ki, kc], axis=1)
        vals = jnp.concatenate([vi, vc], axis=1)
        return _attend_with_sink(qi, keys, vals, sink, mask)

    o = lax.map(block, (jnp.moveaxis(qb, 1, 0), jnp.moveaxis(kw, 1, 0), jnp.moveaxis(vw, 1, 0), jnp.arange(nb)))
    y = jnp.moveaxis(o, 0, 1).reshape(b, n, D_BRANCH) * jax.nn.silu(z)
    if not need_ctx:
        return y, None
    qc = (hc @ w_in[:, :D_BRANCH]).reshape(b, lc, ATTN_KV_HEADS, ATTN_GROUP, ATTN_HEAD_DIM)
    zc = hc @ w_in[:, D_BRANCH + 2 * kvw:]
    oc = _attend_with_sink(qc, kc, vc, sink).reshape(b, lc, D_BRANCH)
    return y, oc * jax.nn.silu(zc)


def setup_inputs(seed: int = 0) -> dict:
    key = jax.random.key(seed)
    ks = jax.random.split(key, 18)
    n_of = [len(range(m, DEPTH, N_MIXERS)) for m in range(N_MIXERS)]
    kvw2 = 2 * ATTN_KV_HEADS * ATTN_HEAD_DIM

    def nrm(k, shape, s):
        return jax.random.normal(k, shape, jnp.float32) * s

    return {
        'x': nrm(ks[0], (BATCH, SEQ, D_MODEL), 1.0),
        'c': nrm(ks[1], (BATCH, D_MODEL), 1.0),
        'ctx': nrm(ks[2], (BATCH, CTX_LEN, D_MODEL), 1.0),
        'c_ctx': nrm(ks[3], (D_MODEL,), 1.0),
        'norm_g': 1.0 + nrm(ks[4], (DEPTH, D_MODEL), 0.02),
        'ada_w': nrm(ks[5], (DEPTH, D_MODEL, 3 * D_MODEL), 0.5 * D_MODEL ** -0.5),
        'ada_b': nrm(ks[6], (DEPTH, 3 * D_MODEL), 0.02),
        'w_out': nrm(ks[7], (DEPTH, D_BRANCH, D_MODEL), D_BRANCH ** -0.5),
        'fnet_w_in': nrm(ks[8], (n_of[0], D_MODEL, 2 * D_BRANCH), D_MODEL ** -0.5),
        'fnet_w_mix': nrm(ks[9], (n_of[0], FNET_GROUPS, FNET_GROUP_DIM, FNET_GROUP_DIM), FNET_GROUP_DIM ** -0.5),
        'attn_w_in': nrm(ks[10], (n_of[1], D_MODEL, 2 * D_BRANCH + kvw2), D_MODEL ** -0.5),
        'attn_sink': nrm(ks[11], (n_of[1], ATTN_Q_HEADS), 0.5),
        'gmlp_w_in': nrm(ks[12], (n_of[2], D_MODEL, 3 * D_BRANCH), D_MODEL ** -0.5),
        'gmlp_w_s': nrm(ks[13], (n_of[2], GMLP_GROUPS, GMLP_CHUNK, GMLP_CHUNK), GMLP_CHUNK ** -0.5),
        'gmlp_b_s': 1.0 + nrm(ks[14], (n_of[2], GMLP_GROUPS, GMLP_CHUNK), 0.02),
        'gmlp_ln_g': 1.0 + nrm(ks[15], (n_of[2], D_BRANCH), 0.02),
        'gmlp_ln_b': nrm(ks[16], (n_of[2], D_BRANCH), 0.02),
        'final_g': 1.0 + nrm(ks[17], (D_MODEL,), 0.02),
    }


def reference(x, c, ctx, c_ctx, norm_g, ada_w, ada_b, w_out, fnet_w_in, fnet_w_mix, attn_w_in, attn_sink,
              gmlp_w_in, gmlp_w_s, gmlp_b_s, gmlp_ln_g, gmlp_ln_b, final_g):
    n = x.shape[1]
    ROWS = n // GRID_W
    rows = jnp.repeat(jnp.arange(ROWS, dtype=jnp.float32), GRID_W)
    cols = jnp.tile(jnp.arange(GRID_W, dtype=jnp.float32), ROWS)
    xc = ctx
    for i in range(DEPTH):
        kind, j = i % N_MIXERS, i // N_MIXERS
        need_ctx = i < DEPTH - 1
        shift, scale, gate = jnp.split((jax.nn.silu(c) @ ada_w[i] + ada_b[i])[:, None, :], 3, axis=-1)
        h = _rmsnorm(x, norm_g[i]) * (1 + scale) + shift
        hc = None
        if need_ctx or kind == 1:
            shift_c, scale_c, gate_c = jnp.split(jax.nn.silu(c_ctx) @ ada_w[i] + ada_b[i], 3)
            hc = _rmsnorm(xc, norm_g[i]) * (1 + scale_c) + shift_c
        if kind == 0:
            y = _fourier_branch(h, fnet_w_in[j], fnet_w_mix[j])
            yc = _fourier_branch(hc, fnet_w_in[j], fnet_w_mix[j]) if need_ctx else None
        elif kind == 1:
            y, yc = _attention_branch(h, hc, attn_w_in[j], attn_sink[j], rows, cols, need_ctx)
        else:
            y = _gmlp_branch(h, gmlp_w_in[j], gmlp_w_s[j], gmlp_b_s[j], gmlp_ln_g[j], gmlp_ln_b[j])
            yc = (_gmlp_branch(hc, gmlp_w_in[j], gmlp_w_s[j], gmlp_b_s[j], gmlp_ln_g[j], gmlp_ln_b[j])
                  if need_ctx else None)
        x = x + gate * (y @ w_out[i])
        if need_ctx:
            xc = xc + gate_c * (yc @ w_out[i])
    return _rmsnorm(x, final_g)
```

```cpp
#include <hip/hip_runtime.h>
#include <hip/hip_cooperative_groups.h>
#include <cstdio>
#include <cstdint>
namespace cg = cooperative_groups;

#ifndef MK_COOP
#define MK_COOP 1
#endif

__device__ __forceinline__ int tidx() { int t = threadIdx.x; asm volatile("" : "+v"(t)); return t; }
namespace pg8 {
#define PG8_LAS __attribute__((address_space(3)))
typedef unsigned short bf16_t;
typedef short bf16x8 __attribute__((ext_vector_type(8)));
typedef float f32x4 __attribute__((ext_vector_type(4)));
typedef unsigned u32x4 __attribute__((ext_vector_type(4)));
constexpr int BM = 256, BK = 64, HALF = 128, HTB = HALF * BK * 2, STAGE_BYTES = 8 * HTB, NXCD = 8, WGM = 8;

__host__ __device__ __forceinline__ int lds_byte(int r, int c) { const int st = (r >> 4) * 2 + (c >> 5), rr = r & 15, cc = c & 31, ob = rr * 64 + cc * 2; return st * 1024 + (ob ^ (((ob >> 9) & 1) << 5)); }
__host__ __device__ __forceinline__ void stage_rc(int b, int& R, int& C) { const int st = b / 1024, sb = b % 1024, swz = sb ^ (((sb >> 9) & 1) << 5); R = (st >> 1) * 16 + swz / 64; C = (st & 1) * 32 + (swz % 64) / 2; }
__host__ __device__ __forceinline__ int perm32(int rho) { const int n = rho >> 4, i = rho & 15; return 8 * (i >> 2) + 4 * n + (i & 3); }

struct Unit { int pm, pn, na, roff; };
struct Gemm { int lda, ldb, K; };

struct StaticOrder {
    int nM, nN, nwg, G, c, nfull;
    __host__ __device__ void init(int M, int N, int G_, int c_, bool split = false) { nM = M / BM; nN = N / BM; nwg = nM * nN; G = G_; c = c_; nfull = nwg;
        if (split) { const int nf = (nwg / G) * G; if (2 * (nwg - nf) <= G) nfull = nf; } }
    __host__ __device__ void map(int wgid, Unit& u) const {
        { const int q = nwg / NXCD, r = nwg % NXCD, xcd = wgid % NXCD, off = wgid / NXCD; wgid = (xcd < r ? xcd * (q + 1) : r * (q + 1) + (xcd - r) * q) + off; }
        const int nig = WGM * nN, gid = wgid / nig, fm = gid * WGM, gsz = (nM - fm) < WGM ? (nM - fm) : WGM;
        u.pm = fm + ((wgid % nig) % gsz); u.pn = (wgid % nig) / gsz; }
    __host__ __device__ bool next(int i, Unit& u) const {
        const long L = (long)i * G + c;
        if (L < nfull) { map((int)L, u); u.na = 2; u.roff = 0; return true; }
        const long h = L - nfull; if (h >= 2L * (nwg - nfull)) return false;
        map(nfull + (int)(h >> 1), u); u.na = 1; u.roff = (int)(h & 1) * HALF; return true;
    }
};

__device__ __forceinline__ unsigned cvt_pk_bf16(float lo, float hi) { unsigned r; asm volatile("v_cvt_pk_bf16_f32 %0, %1, %2" : "=v"(r) : "v"(lo), "v"(hi)); return r; }

struct EpiResid {
    static constexpr bool PERM = false;
    const float* rl; float* xl; const float* gate;
    __device__ __forceinline__ void operator()(const f32x4 (&acc)[2][2][4][2], const Unit& u, int wr, int wc, int fr, int fq) const {
        { int t_ = tidx(); fr = t_ & 15; fq = (t_ >> 4) & 3; }
        const int col0 = u.pn * BM + wc * 32 + 4 * fq; const float* gp = gate + ((u.pm * BM) >> 13) * 6144 + 4096 + col0;
        f32x4 g4[2][2];
#pragma unroll
        for (int bj = 0; bj < 2; ++bj)
#pragma unroll
            for (int n = 0; n < 2; ++n) g4[bj][n] = *(const f32x4*)(gp + bj * HALF + n * 16);
#pragma unroll
        for (int ai = 0; ai < 2; ++ai) {
            f32x4 xv[4][2][2];
#pragma unroll
            for (int m = 0; m < 4; ++m) { const float* rr = rl + (size_t)(u.pm * BM + ai * HALF + wr * 64 + m * 16 + fr) * 2048 + col0;
#pragma unroll
                for (int bj = 0; bj < 2; ++bj)
#pragma unroll
                    for (int n = 0; n < 2; ++n) xv[m][bj][n] = *(const f32x4*)(rr + bj * HALF + n * 16); }
#pragma unroll
            for (int m = 0; m < 4; ++m) { float* xr = xl + (size_t)(u.pm * BM + ai * HALF + wr * 64 + m * 16 + fr) * 2048 + col0;
#pragma unroll
                for (int bj = 0; bj < 2; ++bj)
#pragma unroll
                    for (int n = 0; n < 2; ++n) *(f32x4*)(xr + bj * HALF + n * 16) = xv[m][bj][n] + g4[bj][n] * acc[ai][bj][m][n]; }
            asm volatile("" ::: "memory");
        }
    }
};

__device__ __forceinline__ const char* uni(const char* p) { const unsigned long long v = (unsigned long long)p; const unsigned lo = __builtin_amdgcn_readfirstlane((unsigned)v), hi = __builtin_amdgcn_readfirstlane((unsigned)(v >> 32)); return (const char*)(((unsigned long long)hi << 32) | lo); }
struct EpiPart {
    static constexpr bool PERM = false;
    float* part;
    __device__ __forceinline__ void operator()(const f32x4 (&acc)[2][2][4][2], const Unit& u, int wr, int wc, int fr, int fq) const {
        { int t_ = tidx(); fr = t_ & 15; fq = (t_ >> 4) & 3; }
        const int ks = u.pn >> 3, col0 = (u.pn & 7) * BM + wc * 32 + 4 * fq;
#pragma unroll
        for (int ai = 0; ai < 2; ++ai)
#pragma unroll
            for (int m = 0; m < 4; ++m) { float* o = part + ((size_t)(ks * 512 + u.pm * BM + ai * HALF + wr * 64 + m * 16 + fr)) * 2048 + col0;
#pragma unroll
                for (int bj = 0; bj < 2; ++bj)
#pragma unroll
                    for (int n = 0; n < 2; ++n) *(f32x4*)(o + bj * HALF + n * 16) = acc[ai][bj][m][n]; }
    }
};
template <class Epi, class Sched, bool HALFM = false>
__device__ __forceinline__ void gemm_phase(PG8_LAS unsigned char* lds, const Gemm g, const Sched& S, const Epi& E) {
    int tid_ = tidx();
    const int tid = tid_, wid = __builtin_amdgcn_readfirstlane(tid >> 6), lane = tid & 63, wr = wid >> 2, wc = wid & 3, fr = lane & 15, fq = lane >> 4;
    int K_ = g.K; asm volatile("" : "+s"(K_));
    const int K = K_, nt = K / BK;
    unsigned voffA[2], voffB[2];
#pragma unroll
    for (int i = 0; i < 2; ++i) { int R, C; stage_rc(tid * 16 + i * 8192, R, C); const int Rb = Epi::PERM ? ((R & ~31) + perm32(R & 31)) : R;
        voffA[i] = (unsigned)(R * g.lda + C) * 2u; voffB[i] = (unsigned)(Rb * g.ldb + C) * 2u; }
    const size_t kstep = (size_t)(BK * 2);
    const size_t hstepA = (size_t)HALF * g.lda * 2, hstepB = (size_t)HALF * g.ldb * 2;
    const unsigned ldsw = (unsigned)wid * 1024u;
    const int aoff = lds_byte(wr * 64 + fr, fq * 8), boff = lds_byte(wc * 32 + fr, fq * 8);
#define PG8_SA(b, h) (((b) * 2 + (h)) * HTB)
#define PG8_SB(b, h) ((4 + (b) * 2 + (h)) * HTB)
#define PG8_STAGE(bufoff, gbase, voff) do { _Pragma("unroll") for (int _i = 0; _i < 2; ++_i) \
        __builtin_amdgcn_global_load_lds((const unsigned*)((const char*)(gbase) + (voff)[_i]), (PG8_LAS unsigned*)(lds + (bufoff) + ldsw + _i * 8192), 16, 0, 0); } while (0)
#define PG8_LDA(dst, b, h) do { _Pragma("unroll") for (int m = 0; m < 4; ++m) _Pragma("unroll") for (int k = 0; k < 2; ++k) dst[m][k] = *(const PG8_LAS bf16x8*)(lds + PG8_SA(b, h) + aoff + m * 2048 + k * 1024); } while (0)
#define PG8_LDB(dst, b, h) do { _Pragma("unroll") for (int n = 0; n < 2; ++n) _Pragma("unroll") for (int k = 0; k < 2; ++k) dst[n][k] = *(const PG8_LAS bf16x8*)(lds + PG8_SB(b, h) + boff + n * 2048 + k * 1024); } while (0)
#define PG8_MMA(ai, bj, At, Bt) do { __builtin_amdgcn_s_setprio(1); _Pragma("unroll") for (int m = 0; m < 4; ++m) _Pragma("unroll") for (int n = 0; n < 2; ++n) _Pragma("unroll") for (int k = 0; k < 2; ++k) \
        acc[ai][bj][m][n] = __builtin_amdgcn_mfma_f32_16x16x32_bf16(Bt[n][k], At[m][k], acc[ai][bj][m][n], 0, 0, 0); __builtin_amdgcn_s_setprio(0); } while (0)
#define PG8_WAIT_V(n) asm volatile("s_waitcnt vmcnt(" #n ")" ::: "memory")
#define PG8_WAIT_L(n) asm volatile("s_waitcnt lgkmcnt(" #n ")" ::: "memory")
#define PG8_BAR __builtin_amdgcn_s_barrier()
#define PG8_SCHED __builtin_amdgcn_sched_barrier(0)
    Unit cur, nxt; int ui = 0;
    if (!S.next(0, cur)) return;
    f32x4 acc[2][2][4][2];
#pragma unroll
    for (int a = 0; a < 2; ++a)
#pragma unroll
        for (int b = 0; b < 2; ++b)
#pragma unroll
            for (int m = 0; m < 4; ++m)
#pragma unroll
                for (int n = 0; n < 2; ++n) acc[a][b][m][n] = (f32x4){0.f, 0.f, 0.f, 0.f};
    bf16x8 At[4][2], B0[2][2], B1[2][2];
    const char* cA = uni(S.aptr(cur)); const char* cB = uni(S.bptr(cur));
    {
        PG8_STAGE(PG8_SB(0, 0), cB, voffB); PG8_STAGE(PG8_SB(0, 1), cB + hstepB, voffB); PG8_STAGE(PG8_SA(0, 0), cA, voffA); PG8_STAGE(PG8_SA(0, 1), cA + hstepA, voffA);
        if (wr == 1) PG8_BAR;
        PG8_WAIT_V(2); PG8_BAR;
        PG8_STAGE(PG8_SB(1, 0), cB + kstep, voffB); PG8_STAGE(PG8_SA(1, 0), cA + kstep, voffA); PG8_STAGE(PG8_SB(1, 1), cB + hstepB + kstep, voffB);
        PG8_WAIT_V(6); PG8_BAR;
    }
    for (;;) {
        const bool has_next = S.next(ui + 1, nxt);
        const char* nA = has_next ? uni(S.aptr(nxt)) : cA; const char* nB = has_next ? uni(S.bptr(nxt)) : cB;
        for (int t = 0; t < nt; t += 2) {
            const bool last = (t == nt - 2);
            const char* a1 = cA + (size_t)(t + 1) * kstep;
            const char* a2 = last ? nA : cA + (size_t)(t + 2) * kstep; const char* b2 = last ? nB : cB + (size_t)(t + 2) * kstep;
            const char* a3 = a2 + kstep; const char* b3 = b2 + kstep;
            PG8_LDB(B0, 0, 0); PG8_LDB(B1, 0, 1); PG8_SCHED; PG8_LDA(At, 0, 0); PG8_STAGE(PG8_SA(1, 1), a1 + hstepA, voffA);
            PG8_WAIT_V(8); PG8_WAIT_L(0); PG8_BAR; PG8_MMA(0, 0, At, B0); PG8_MMA(0, 1, At, B1); PG8_BAR; PG8_SCHED;
            PG8_LDA(At, 0, 1); PG8_STAGE(PG8_SB(0, 0), b2, voffB); PG8_STAGE(PG8_SB(0, 1), b2 + hstepB, voffB); PG8_STAGE(PG8_SA(0, 0), a2, voffA);
            PG8_WAIT_V(8); PG8_WAIT_L(0); PG8_BAR; if (HALFM ? false : cur.na == 2) { PG8_MMA(1, 0, At, B0); PG8_MMA(1, 1, At, B1); } PG8_BAR; PG8_SCHED;
            PG8_LDB(B0, 1, 0); PG8_LDB(B1, 1, 1); PG8_SCHED; PG8_LDA(At, 1, 0); PG8_STAGE(PG8_SA(0, 1), a2 + hstepA, voffA);
            PG8_WAIT_V(8); PG8_WAIT_L(0); PG8_BAR; PG8_MMA(0, 0, At, B0); PG8_MMA(0, 1, At, B1); PG8_BAR; PG8_SCHED;
            PG8_LDA(At, 1, 1); PG8_STAGE(PG8_SB(1, 0), b3, voffB); PG8_STAGE(PG8_SB(1, 1), b3 + hstepB, voffB); PG8_STAGE(PG8_SA(1, 0), a3, voffA);
            PG8_WAIT_V(8); PG8_WAIT_L(0); PG8_BAR; if (HALFM ? false : cur.na == 2) { PG8_MMA(1, 0, At, B0); PG8_MMA(1, 1, At, B1); } PG8_BAR; PG8_SCHED;
        }
        if (wr == 0) PG8_BAR;
        E(acc, cur, wr, wc, fr, fq);
        if (!has_next) break;
#pragma unroll
        for (int a = 0; a < 2; ++a)
#pragma unroll
            for (int b = 0; b < 2; ++b)
#pragma unroll
                for (int m = 0; m < 4; ++m)
#pragma unroll
                    for (int n = 0; n < 2; ++n) acc[a][b][m][n] = (f32x4){0.f, 0.f, 0.f, 0.f};
        cur = nxt; cA = nA; cB = nB; ++ui;
        if (wr == 1) PG8_BAR;
    }
    PG8_WAIT_V(0);
    PG8_BAR;
#undef PG8_SA
#undef PG8_SB
#undef PG8_STAGE
#undef PG8_LDA
#undef PG8_LDB
#undef PG8_MMA
#undef PG8_WAIT_V
#undef PG8_WAIT_L
#undef PG8_BAR
#undef PG8_SCHED
}
}

typedef unsigned short bf16;
typedef float f32x4 __attribute__((ext_vector_type(4)));
typedef unsigned u32x4 __attribute__((ext_vector_type(4)));
typedef unsigned u32x2 __attribute__((ext_vector_type(2)));
constexpr int DM = 2048, SEQ = 8192, ML = 16384, MC = 512, MT = ML + MC, DBR = 4096, CTXL = 256, DEPTH = 4;
constexpr int NTHR = 512, NWAVES = 8;
constexpr float EPS = 1e-6f;
constexpr size_t MiB = 1u << 20;
constexpr size_t WS_MOD = 0;
constexpr size_t WS_BAR = 512 * 1024;
constexpr size_t WS_XC = 1 * MiB;
constexpr size_t WS_TAB = 5 * MiB;
constexpr size_t TAB_ROPE = WS_TAB + 65536, TAB_DA = WS_TAB + 131072, TAB_CASPM = WS_TAB + 262144;
constexpr size_t WS_WIN = 8 * MiB;
constexpr size_t WS_WOUT = 56 * MiB;
constexpr size_t WS_BMIX = 72 * MiB;
constexpr size_t WS_HB = 76 * MiB;
constexpr size_t WS_PB = 142 * MiB;
constexpr size_t WS_YB = 538 * MiB;
constexpr size_t WS_QB = 142 * MiB;
constexpr size_t WS_KB = 274 * MiB;
constexpr size_t WS_VT = 291 * MiB;
constexpr size_t WS_VTC = 307 * MiB;
constexpr size_t WS_ZA = 308 * MiB;
constexpr size_t WS_UG = 142 * MiB;
constexpr size_t WS_VG = 274 * MiB;
constexpr size_t WS_ZG = 406 * MiB;
constexpr size_t WS_VT2 = 538 * MiB;
constexpr size_t WS_STAT = 670 * MiB;
constexpr size_t WS_WSB = 72 * MiB;
constexpr size_t WS_TO = 76 * MiB;
constexpr size_t WS_U1 = 142 * MiB;
constexpr size_t WS_UCT = 270 * MiB;
constexpr size_t WS_ZB = 340 * MiB;
constexpr size_t WS_YP = 472 * MiB;
constexpr size_t WS_YB_F = 472 * MiB;
constexpr size_t TAB_DC2 = 760 * MiB;
constexpr size_t WS_PART = 728 * MiB;
constexpr size_t WS_END = 768 * MiB;
static_assert(WS_YP + (size_t)256 * MiB <= WS_END && WS_YB + (size_t)MT * DBR * 2 <= WS_END, "ws map");
constexpr int LDS_BYTES = 135168;

struct Params { const float* in[18]; float* out; unsigned char* ws; int ph_lo, ph_hi; };

__device__ __forceinline__ float bf2f(bf16 h) { return __uint_as_float((unsigned)h << 16); }
__device__ __forceinline__ unsigned f2bf(float f) { unsigned u = __float_as_uint(f); return (u + 0x7fffu + ((u >> 16) & 1u)) >> 16; }
__device__ __forceinline__ unsigned pk2(float lo, float hi) { return f2bf(lo) | (f2bf(hi) << 16); }
__device__ __forceinline__ float silu_f(float x) { return x * __builtin_amdgcn_rcpf(1.f + __builtin_amdgcn_exp2f(-1.4426950408889634f * x)); }
__device__ __forceinline__ float wave_sum(float v) {
#pragma unroll
    for (int o = 1; o < 64; o <<= 1) v += __shfl_xor(v, o);
    return v;
}
#define LDS_WAIT() asm volatile("s_waitcnt lgkmcnt(0)" ::: "memory")

struct SchedLin : pg8::StaticOrder {
    const char* A0; const char* B0; size_t sAm, sAn, sBm, sBn;
    __device__ __forceinline__ const char* aptr(const pg8::Unit& u) const { return A0 + u.pm * sAm + u.pn * sAn + (size_t)u.roff * (sAm >> 8); }
    __device__ __forceinline__ const char* bptr(const pg8::Unit& u) const { return B0 + u.pm * sBm + u.pn * sBn; }
    __device__ __forceinline__ void plain(const void* A, int lda, const void* B, int ldb) { A0 = (const char*)A; B0 = (const char*)B; sAm = (size_t)256 * lda * 2; sAn = 0; sBm = 0; sBn = (size_t)256 * ldb * 2; }
};

__device__ __forceinline__ void phase0(const Params& p, unsigned char* lds) {
    const int tid = tidx(), lane = tid & 63, wave = tid >> 6, G = gridDim.x, bid = blockIdx.x;
    float* sv = (float*)lds;
    float* red = sv + 3 * 2048;
    const float* c = p.in[1]; const float* cctx = p.in[3];
    for (int i = tid; i < 3 * 2048; i += NTHR) { const float v = i < 4096 ? c[i] : cctx[i - 4096]; sv[i] = silu_f(v); }
    __syncthreads();
    float* mod = (float*)(p.ws + WS_MOD);
    const float* ada_w = p.in[5]; const float* ada_b = p.in[6];
    typedef float f32x2 __attribute__((ext_vector_type(2)));
    for (int it = bid; it < 4 * 48; it += G) {
        const int L = it / 48, jg = it % 48;
        const float* w = ada_w + (size_t)L * 2048 * 6144 + jg * 128 + 2 * lane;
        f32x2 a0 = {0.f, 0.f}, a1 = {0.f, 0.f}, a2 = {0.f, 0.f};
#pragma unroll 16
        for (int k = wave * 256; k < wave * 256 + 256; ++k) { const f32x2 wv = __builtin_nontemporal_load((const f32x2*)(w + (size_t)k * 6144)); a0 += sv[k] * wv; a1 += sv[2048 + k] * wv; a2 += sv[4096 + k] * wv; }
        f32x2* red2 = (f32x2*)red;
        red2[(wave * 3 + 0) * 64 + lane] = a0; red2[(wave * 3 + 1) * 64 + lane] = a1; red2[(wave * 3 + 2) * 64 + lane] = a2;
        __syncthreads();
        if (tid < 192) { const int v = tid >> 6, l = tid & 63; f32x2 s = {0.f, 0.f};
#pragma unroll
            for (int w8 = 0; w8 < 8; ++w8) s += red2[(w8 * 3 + v) * 64 + l];
            const f32x2 bb = *(const f32x2*)(ada_b + L * 6144 + jg * 128 + 2 * l);
            *(f32x2*)(mod + (size_t)(L * 3 + v) * 6144 + jg * 128 + 2 * l) = s + bb; }
        __syncthreads();
    }
    const int gt = bid * NTHR + tid, NT = G * NTHR;
    float* rope = (float*)(p.ws + TAB_ROPE);
    for (int j = gt; j < 128 * 16; j += NT) { const int pos = j >> 4, i = j & 15;
        const float inv = exp2f(-(float)i * (13.287712379549449f / 16.f)); const float ang = (float)pos * inv;
        double td = (double)ang * 0.15915494309189535; td -= floor(td); const float tf = (float)td;
        rope[2 * j] = __builtin_amdgcn_cosf(tf); rope[2 * j + 1] = __builtin_amdgcn_sinf(tf); }
    bf16* DA = (bf16*)(p.ws + TAB_DA); bf16* CPM = (bf16*)(p.ws + TAB_CASPM);
    for (int j = gt; j < 256 * 128; j += NT) { const int r = j >> 7, cc = j & 127;
        { const int k1 = r & 127; const float t = (float)((k1 * cc) & 127) * (1.f / 128.f); DA[j] = (bf16)f2bf(r < 128 ? __builtin_amdgcn_cosf(t) : -__builtin_amdgcn_sinf(t)); } }
    { bf16* DC2 = (bf16*)(p.ws + TAB_DC2);
      for (int j = gt; j < 129 * 128 * 128; j += NT) { const int cc = j & 127, r = (j >> 7) & 127, k1 = (j >> 14) & 127, ty = r >> 6, k2 = r & 63, n2 = cc >> 1, ri = cc & 1;
          const float t = (float)(((128 * k2 + k1) * n2) & 8191) * (1.f / 8192.f); const float c_ = __builtin_amdgcn_cosf(t), s_ = __builtin_amdgcn_sinf(t);
          DC2[j] = (bf16)f2bf(ty == 1 ? (ri == 0 ? c_ + s_ : s_ - c_) : (ri == 0 ? c_ - s_ : s_ + c_)); } }
    for (int j = gt; j < 512 * 256; j += NT) { const int r = j >> 8, n = j & 255, k = r & 255; const float t = (float)((k * n) & 255) * (1.f / 256.f); const float c_ = __builtin_amdgcn_cosf(t), s_ = __builtin_amdgcn_sinf(t);
        CPM[j] = (bf16)f2bf(r < 256 ? c_ - s_ : c_ + s_); }
}

__device__ __forceinline__ void transpose_all(const float* W, int ldw, int K, int ncols, bf16* WT, unsigned char* lds, int vb = -1, int nvb = 0) {
    const int tid = tidx(); float* tile = (float*)lds;
    const int nblk = ncols / 256, nitems = (K / 64) * nblk;
    if (vb < 0) { vb = blockIdx.x; nvb = gridDim.x; }
    f32x4 v[8];
    int it = vb;
    if (it < nitems) { const int k0 = 64 * (it / nblk), n0 = 256 * (it % nblk);
#pragma unroll
        for (int i = 0; i < 8; ++i) { const int pc = tid + i * NTHR, kk = pc >> 6, c4 = (pc & 63) * 4; v[i] = __builtin_nontemporal_load((const f32x4*)(W + (size_t)(k0 + kk) * ldw + n0 + c4)); } }
    for (; it < nitems; it += nvb) {
        const int kb = it / nblk, nb = it % nblk, k0 = 64 * kb, n0 = 256 * nb;
        __syncthreads();
#pragma unroll
        for (int i = 0; i < 8; ++i) { const int pc = tid + i * NTHR, kk = pc >> 6, c4 = (pc & 63) * 4; *(f32x4*)(tile + kk * 260 + c4) = v[i]; }
        const int itn = it + nvb;
        if (itn < nitems) { const int k0n = 64 * (itn / nblk), n0n = 256 * (itn % nblk);
#pragma unroll
            for (int i = 0; i < 8; ++i) { const int pc = tid + i * NTHR, kk = pc >> 6, c4 = (pc & 63) * 4; v[i] = __builtin_nontemporal_load((const f32x4*)(W + (size_t)(k0n + kk) * ldw + n0n + c4)); } }
        __syncthreads();
        const int n = tid & 255, kh = (tid >> 8) * 32; const float* sp = tile + kh * 260 + n; bf16* o = WT + (size_t)(n0 + n) * K + k0 + kh;
#pragma unroll
        for (int q = 0; q < 4; ++q) { u32x4 w; w.x = pk2(sp[(8 * q) * 260], sp[(8 * q + 1) * 260]); w.y = pk2(sp[(8 * q + 2) * 260], sp[(8 * q + 3) * 260]); w.z = pk2(sp[(8 * q + 4) * 260], sp[(8 * q + 5) * 260]); w.w = pk2(sp[(8 * q + 6) * 260], sp[(8 * q + 7) * 260]);
            *(u32x4*)(o + 8 * q) = w; }
    }
    __syncthreads();
}
__device__ __forceinline__ void hartley_fold(const float* W  , bf16* WT, unsigned char* lds) {
    float* tile = (float*)lds;
    float* cas = tile + 64 * 260;
    const int tid = tidx();
    for (int it = blockIdx.x; it < 16 * 32; it += gridDim.x) {
        const int g = it >> 5, k0 = (it & 31) * 64;
        __syncthreads();
        { f32x4 v[8];
#pragma unroll
          for (int i = 0; i < 8; ++i) { const int pc = tid + i * NTHR, kk = pc >> 6, c4 = (pc & 63) * 4; v[i] = __builtin_nontemporal_load((const f32x4*)(W + (size_t)(k0 + kk) * 8192 + g * 256 + c4)); }
#pragma unroll
          for (int i = 0; i < 8; ++i) { const int pc = tid + i * NTHR, kk = pc >> 6, c4 = (pc & 63) * 4; *(f32x4*)(tile + kk * 260 + c4) = v[i]; } }
        if (tid < 256) { const float t = (float)tid * (1.f / 256.f); cas[tid] = __builtin_amdgcn_cosf(t) + __builtin_amdgcn_sinf(t); }
        __syncthreads();
        const int l0 = tid & 63, kg = (tid >> 6) * 8;
        float acc[8][4];
#pragma unroll
        for (int kk = 0; kk < 8; ++kk)
#pragma unroll
            for (int jj = 0; jj < 4; ++jj) acc[kk][jj] = 0.f;
#pragma unroll 2
        for (int cc = 0; cc < 256; ++cc) { float w[4];
#pragma unroll
            for (int jj = 0; jj < 4; ++jj) w[jj] = cas[((l0 + 64 * jj) * cc) & 255];
#pragma unroll
            for (int kk = 0; kk < 8; ++kk) { const float tv = tile[(kg + kk) * 260 + cc];
#pragma unroll
                for (int jj = 0; jj < 4; ++jj) acc[kk][jj] += tv * w[jj]; } }
#pragma unroll
        for (int jj = 0; jj < 4; ++jj) { u32x4 w; w.x = pk2(acc[0][jj], acc[1][jj]); w.y = pk2(acc[2][jj], acc[3][jj]); w.z = pk2(acc[4][jj], acc[5][jj]); w.w = pk2(acc[6][jj], acc[7][jj]);
            *(u32x4*)(WT + (size_t)(g * 256 + l0 + 64 * jj) * 2048 + k0 + kg) = w; }
    }
    __syncthreads();
}
__device__ __forceinline__ void norm_rows(const Params& p, int L, int nrows, bool perm) {
    const int lane = tidx() & 63, gw = blockIdx.x * NWAVES + (tidx() >> 6), NGW = gridDim.x * NWAVES;
    const float* gvec = p.in[4] + L * 2048; const float* mod = (const float*)(p.ws + WS_MOD) + (size_t)L * 3 * 6144;
    bf16* HB = (bf16*)(p.ws + WS_HB);
    const float* xl = L == 0 ? p.in[0] : p.out; const float* xcx = L <= 1 ? p.in[2] : (const float*)(p.ws + WS_XC);
#define NR_SRC(r) ((r) < ML ? xl + (size_t)(r) * DM : xcx + (size_t)((r) - ML) * DM)
    f32x4 x[8], xn[8];
    int row = gw;
    if (row < nrows) { const float* xr = NR_SRC(row);
#pragma unroll
        for (int j = 0; j < 8; ++j) x[j] = *(const f32x4*)(xr + 4 * lane + 256 * j); }
    for (; row < nrows; row += NGW) {
        const int rn = row + NGW;
        if (rn < nrows) { const float* xr = NR_SRC(rn);
#pragma unroll
            for (int j = 0; j < 8; ++j) xn[j] = *(const f32x4*)(xr + 4 * lane + 256 * j); }
        const int v = row < ML ? (row >> 13) : 2; const float* sh = mod + v * 6144; const float* sc = sh + 2048;
        const int orow = (perm && row < ML) ? ((row & ~8191) + ((row & 63) << 7) + ((row & 8191) >> 6)) : row;
        bool emit = true;
        if (row >= ML && L >= 1) {
            const float* gp = mod - 3 * 6144 + 2 * 6144 + 4096; const float* pp = (const float*)(p.ws + WS_PART) + (size_t)(row - ML) * 2048; float* xw = (float*)(p.ws + WS_XC) + (size_t)(row - ML) * DM;
#pragma unroll
            for (int j = 0; j < 8; ++j) { const int c0 = 4 * lane + 256 * j; f32x4 a = *(const f32x4*)(pp + c0);
#pragma unroll
                for (int ks = 1; ks < 8; ++ks) a = a + *(const f32x4*)(pp + (size_t)ks * 512 * 2048 + c0);
                x[j] = x[j] + *(const f32x4*)(gp + c0) * a; *(f32x4*)(xw + c0) = x[j];
                asm volatile("" ::: "memory"); }
            emit = L != 3;
        }
        if (emit) {
            float s = 0.f;
#pragma unroll
            for (int j = 0; j < 8; ++j) s += (x[j].x * x[j].x + x[j].y * x[j].y) + (x[j].z * x[j].z + x[j].w * x[j].w);
            const float rstd = rsqrtf(wave_sum(s) * (1.f / DM) + EPS);
#pragma unroll
            for (int j = 0; j < 8; ++j) { const int c0 = 4 * lane + 256 * j; const f32x4 g4 = *(const f32x4*)(gvec + c0), s4 = *(const f32x4*)(sc + c0), h4 = *(const f32x4*)(sh + c0);
                const f32x4 y = x[j] * rstd * g4 * (1.f + s4) + h4; u32x2 w; w.x = pk2(y.x, y.y); w.y = pk2(y.z, y.w); *(u32x2*)(HB + (size_t)orow * DM + c0) = w; }
        }
#pragma unroll
        for (int j = 0; j < 8; ++j) x[j] = xn[j];
    }
#undef NR_SRC
}
template <int L> __device__ __forceinline__ void phase_prep(const Params& p, unsigned char* lds) {
    constexpr int kind = L % 3, j = L / 3;
    bf16* WIN = (bf16*)(p.ws + WS_WIN); bf16* WOUT = (bf16*)(p.ws + WS_WOUT);
    if (kind == 0) { const float* W = p.in[8] + (size_t)j * 2048 * 8192;
        hartley_fold(W, WIN, lds);
        transpose_all(W + 4096, 8192, 2048, 4096, WIN + (size_t)4096 * 2048, lds);
        { const float* wmix = p.in[9] + (size_t)j * 16 * 65536; bf16* BM = (bf16*)(p.ws + WS_BMIX);
          for (int base = blockIdx.x * NTHR + tidx(); base < 16 * 256 * 512; base += 8 * gridDim.x * NTHR) { float v[8];
#pragma unroll
              for (int e = 0; e < 8; ++e) { const int idx = base + e * gridDim.x * NTHR; const int jj = idx & 511, d = (idx >> 9) & 255, g = idx >> 17, l = jj < 256 ? jj : ((512 - jj) & 255);
                  v[e] = idx < 16 * 256 * 512 ? wmix[(size_t)g * 65536 + l * 256 + d] : 0.f; }
#pragma unroll
              for (int e = 0; e < 8; ++e) { const int idx = base + e * gridDim.x * NTHR; if (idx < 16 * 256 * 512) BM[idx] = (bf16)f2bf(v[e]); } } }
    } else if (kind == 1) transpose_all(p.in[10], 9216, 2048, 9216, WIN, lds);
    else { transpose_all(p.in[12], 12288, 2048, 12288, WIN, lds);
        bf16* WSB = (bf16*)(p.ws + WS_WSB); const float* wsp = p.in[13];
        for (int idx = blockIdx.x * NTHR + tidx(); idx < 16 * 128 * 128; idx += gridDim.x * NTHR) WSB[idx] = (bf16)f2bf(wsp[idx]); }
    transpose_all(p.in[7] + (size_t)L * 4096 * 2048, 2048, 4096, 2048, WOUT, lds);
    norm_rows(p, L, MT, kind == 0);
}

struct SchedCtxOut : pg8::StaticOrder {
    const char* A0; const char* B0;
    __device__ __forceinline__ const char* aptr(const pg8::Unit& u) const { return A0 + (size_t)u.pm * (256 * 4096 * 2) + (u.pn >> 3) * 1024; }
    __device__ __forceinline__ const char* bptr(const pg8::Unit& u) const { return B0 + (size_t)(u.pn & 7) * (256 * 4096 * 2) + (u.pn >> 3) * 1024; }
};
template <int L> __device__ __forceinline__ void phase_outproj(const Params& p, unsigned char* lds) {
    const unsigned char* Y = p.ws + (L % 3 == 0 ? WS_YB_F : (L % 3 == 1 ? WS_YB : WS_UG));
    { pg8::Gemm g{DBR, DBR, DBR};
      SchedLin S; S.init(ML, DM, gridDim.x, blockIdx.x); S.plain(Y, DBR, p.ws + WS_WOUT, DBR);
      pg8::EpiResid E{L == 0 ? p.in[0] : p.out, p.out, (const float*)(p.ws + WS_MOD) + (size_t)L * 3 * 6144};
      pg8::gemm_phase<pg8::EpiResid, SchedLin>((PG8_LAS unsigned char*)lds, g, S, E); }
    if (L < 3) {
        pg8::Gemm g{DBR, DBR, 512};
        SchedCtxOut S; S.init(MC, 64 * 256, gridDim.x, blockIdx.x); S.A0 = (const char*)(Y + (size_t)ML * DBR * 2); S.B0 = (const char*)(p.ws + WS_WOUT);
        pg8::EpiPart E{(float*)(p.ws + WS_PART)};
        pg8::gemm_phase<pg8::EpiPart, SchedCtxOut>((PG8_LAS unsigned char*)lds, g, S, E);
    }
}

using pg8::Unit;
__device__ __forceinline__ u32x4 pack8(const pg8::f32x4& a, const pg8::f32x4& b) { u32x4 w; w.x = pg8::cvt_pk_bf16(a[0], a[1]); w.y = pg8::cvt_pk_bf16(a[2], a[3]); w.z = pg8::cvt_pk_bf16(b[0], b[1]); w.w = pg8::cvt_pk_bf16(b[2], b[3]); return w; }
struct SchedFnetIn : pg8::StaticOrder {
    const char* HBp; const char* WINp;
    __device__ __forceinline__ const char* aptr(const Unit& u) const { return (u.pn < 16 ? WINp + (size_t)u.pn * (256 * 2048 * 2) : HBp + (size_t)u.pm * (256 * 2048 * 2)) + (size_t)u.roff * (2048 * 2); }
    __device__ __forceinline__ const char* bptr(const Unit& u) const { return u.pn < 16 ? HBp + (size_t)u.pm * (256 * 2048 * 2) : WINp + (size_t)u.pn * (256 * 2048 * 2); }
};
struct EpiFnetIn {
    static constexpr bool PERM = true;
    unsigned char* ws;
    __device__ __forceinline__ void operator()(const pg8::f32x4 (&acc)[2][2][4][2], const Unit& u, int wr, int wc, int fr, int fq) const {
        bf16* const U1 = (bf16*)(ws + WS_U1); bf16* const UCT = (bf16*)(ws + WS_UCT); bf16* const ZB = (bf16*)(ws + WS_ZB);
        { int t_ = tidx(); fr = t_ & 15; fq = (t_ >> 4) & 3; }
        if (u.pn < 16) {
#pragma unroll
            for (int ai = 0; ai < 2; ++ai)
#pragma unroll
                for (int m = 0; m < 4; ++m) { if (ai >= u.na) break; const int c = u.pn * 256 + u.roff + ai * 128 + wr * 64 + m * 16 + fr;
#pragma unroll
                    for (int bj = 0; bj < 2; ++bj) { const int tcol = bj * 128 + wc * 32 + 8 * fq; bf16* dst;
                        if (u.pm < 64) { const int rp = u.pm * 256 + tcol, b = rp >> 13, r = rp & 8191, n2 = r >> 7, n1 = r & 127; dst = U1 + ((size_t)(b * 4096 + c) * 64 + n2) * 128 + n1; }
                        else dst = UCT + ((size_t)((u.pm - 64) * 4096 + c) * 256 + tcol);
                        *(u32x4*)dst = pack8(acc[ai][bj][m][0], acc[ai][bj][m][1]); } }
        } else {
#pragma unroll
            for (int ai = 0; ai < 2; ++ai)
#pragma unroll
                for (int m = 0; m < 4; ++m) { if (ai >= u.na) break; const int rp = u.pm * 256 + u.roff + ai * 128 + wr * 64 + m * 16 + fr; int row = rp;
                    if (rp < ML) { const int r = rp & 8191; row = (rp & ~8191) + ((r & 127) << 6) + (r >> 7); }
#pragma unroll
                    for (int bj = 0; bj < 2; ++bj) { const int zc = (u.pn - 16) * 256 + bj * 128 + wc * 32 + 8 * fq; pg8::f32x4 a = acc[ai][bj][m][0], b = acc[ai][bj][m][1];
#pragma unroll
                        for (int e = 0; e < 4; ++e) { a[e] = silu_f(a[e]); b[e] = silu_f(b[e]); }
                        *(u32x4*)(ZB + (size_t)row * 4096 + zc) = pack8(a, b); } }
        }
    }
};
template <int L> __device__ __forceinline__ void phase_inproj_fnet(const Params& p, unsigned char* lds) {
    constexpr int M = L == 3 ? ML : MT;
    pg8::Gemm g{DM, DM, DM};
    SchedFnetIn S; S.init(M, 8192, gridDim.x, blockIdx.x, true); S.HBp = (const char*)(p.ws + WS_HB); S.WINp = (const char*)(p.ws + WS_WIN);
    EpiFnetIn E{p.ws};
    pg8::gemm_phase<EpiFnetIn, SchedFnetIn>((PG8_LAS unsigned char*)lds, g, S, E);
}
struct EpiStageA {
    static constexpr bool PERM = true;
    bf16* YP;
    __device__ __forceinline__ void operator()(const pg8::f32x4 (&acc)[2][2][4][2], const Unit& u, int wr, int wc, int fr, int fq) const {
        { int t_ = tidx(); fr = t_ & 15; fq = (t_ >> 4) & 3; }
#pragma unroll
        for (int m = 0; m < 4; ++m) { const int k1 = wr * 64 + m * 16 + fr;
#pragma unroll
            for (int bj = 0; bj < 2; ++bj) { const int idx = u.pn * 256 + bj * 128 + wc * 32 + 8 * fq, n2 = idx & 63, c = (idx >> 6) & 4095, b = idx >> 18;
                bf16* dst = YP + ((((size_t)(b * 128 + k1) * 4096 + c) * 64 + n2) << 1);
#pragma unroll
                for (int h = 0; h < 2; ++h) { const pg8::f32x4 re = acc[0][bj][m][h], im = acc[1][bj][m][h];
                    u32x4 w; w.x = pg8::cvt_pk_bf16(re[0], im[0]); w.y = pg8::cvt_pk_bf16(re[1], im[1]); w.z = pg8::cvt_pk_bf16(re[2], im[2]); w.w = pg8::cvt_pk_bf16(re[3], im[3]);
                    *(u32x4*)(dst + 8 * h) = w; } } }
    }
};
struct EpiCtxH {
    static constexpr bool PERM = true;
    bf16* TO;
    __device__ __forceinline__ void operator()(const pg8::f32x4 (&acc)[2][2][4][2], const Unit& u, int wr, int wc, int fr, int fq) const {
        { int t_ = tidx(); fr = t_ & 15; fq = (t_ >> 4) & 3; }
        const int b = u.pn >> 4, g = u.pn & 15;
#pragma unroll
        for (int ai = 0; ai < 2; ++ai)
#pragma unroll
            for (int m = 0; m < 4; ++m) { const int k = ai * 128 + wr * 64 + m * 16 + fr;
#pragma unroll
                for (int bj = 0; bj < 2; ++bj) { const int l = bj * 128 + wc * 32 + 8 * fq;
                    *(u32x4*)(TO + ((size_t)(ML + b * 256 + k) * 16 + g) * 512 + u.pm * 256 + l) = pack8(acc[ai][bj][m][0], acc[ai][bj][m][1]); } }
    }
};
__device__ __forceinline__ void phase_fnet_a(const Params& p, bool ctx, unsigned char* lds) {
    if (ctx) {
        pg8::Gemm g{256, 256, 256};
        SchedLin S; S.init(512, 8192, gridDim.x, blockIdx.x); S.A0 = (const char*)(p.ws + TAB_CASPM); S.B0 = (const char*)(p.ws + WS_UCT); S.sAm = 256 * 256 * 2; S.sAn = 0; S.sBm = 0; S.sBn = 256 * 256 * 2;
        EpiCtxH E{(bf16*)(p.ws + WS_TO)};
        pg8::gemm_phase<EpiCtxH, SchedLin>((PG8_LAS unsigned char*)lds, g, S, E);
    }
    pg8::Gemm g{128, 128, 128};
    SchedLin S; S.init(256, 2 * 4096 * 64, gridDim.x, blockIdx.x); S.A0 = (const char*)(p.ws + TAB_DA); S.B0 = (const char*)(p.ws + WS_U1); S.sAm = 0; S.sAn = 0; S.sBm = 0; S.sBn = 256 * 128 * 2;
    EpiStageA E{(bf16*)(p.ws + WS_YP)};
    pg8::gemm_phase<EpiStageA, SchedLin>((PG8_LAS unsigned char*)lds, g, S, E);
}
struct EpiStageC {
    static constexpr bool PERM = true;
    bf16* TO;
    __device__ __forceinline__ void operator()(const pg8::f32x4 (&acc)[2][2][4][2], const Unit& u, int wr, int wc, int fr, int fq) const {
        { int t_ = tidx(); fr = t_ & 15; fq = (t_ >> 4) & 3; }
        const int idx = u.pn * 256, g = (idx & 4095) >> 8, k1 = (idx >> 12) & 127, b = idx >> 19;
#pragma unroll
        for (int m = 0; m < 4; ++m) { const int k2 = m * 16 + fr; const size_t row = (size_t)b * 8192 + k1 + 128 * k2;
#pragma unroll
            for (int bj = 0; bj < 2; ++bj) { const int l = bj * 128 + wc * 32 + 8 * fq;
                *(u32x4*)(TO + (row * 16 + g) * 512 + wr * 256 + l) = pack8(acc[0][bj][m][0], acc[0][bj][m][1]); } }
    }
};
struct SchedStageC : pg8::StaticOrder {
    const char* A0; const char* B0; size_t sBn;
    __device__ __forceinline__ const char* aptr(const Unit& u) const { return A0 + (size_t)((u.pn >> 4) & 127) * (128 * 128 * 2); }
    __device__ __forceinline__ const char* bptr(const Unit& u) const { return B0 + u.pn * sBn; }
};
__device__ __forceinline__ void phase_fnet_c(const Params& p, unsigned char* lds) {
    pg8::Gemm g{128, 128, 128};
    SchedStageC S; S.init(256, 2 * 128 * 4096, gridDim.x, blockIdx.x); S.A0 = (const char*)(p.ws + TAB_DC2); S.B0 = (const char*)(p.ws + WS_YP); S.sBn = 256 * 128 * 2;
    EpiStageC E{(bf16*)(p.ws + WS_TO)};
    pg8::gemm_phase<EpiStageC, SchedStageC, true>((PG8_LAS unsigned char*)lds, g, S, E);
}
struct EpiMix {
    static constexpr bool PERM = true;
    const bf16* ZB; bf16* YB;
    __device__ __forceinline__ void operator()(const pg8::f32x4 (&acc)[2][2][4][2], const Unit& u, int wr, int wc, int fr, int fq) const {
        { int t_ = tidx(); fr = t_ & 15; fq = (t_ >> 4) & 3; }
#pragma unroll
        for (int ai = 0; ai < 2; ++ai) {
            if (ai >= u.na) break;
            u32x4 zv[4][2];
#pragma unroll
            for (int m = 0; m < 4; ++m)
#pragma unroll
                for (int bj = 0; bj < 2; ++bj) zv[m][bj] = *(const u32x4*)(ZB + (size_t)(u.pm * 256 + u.roff + ai * 128 + wr * 64 + m * 16 + fr) * 4096 + u.pn * 256 + bj * 128 + wc * 32 + 8 * fq);
#pragma unroll
            for (int m = 0; m < 4; ++m) { const int row = u.pm * 256 + u.roff + ai * 128 + wr * 64 + m * 16 + fr; const float sc = row < ML ? 0.5f * 6.9053396600248786e-4f : 0.5f / 256.f;
#pragma unroll
                for (int bj = 0; bj < 2; ++bj) { const size_t off = (size_t)row * 4096 + u.pn * 256 + bj * 128 + wc * 32 + 8 * fq;
                    const u32x4 z = zv[m][bj]; pg8::f32x4 a = acc[ai][bj][m][0] * sc, b = acc[ai][bj][m][1] * sc;
                    a[0] *= __uint_as_float(z.x << 16); a[1] *= __uint_as_float(z.x & 0xffff0000u); a[2] *= __uint_as_float(z.y << 16); a[3] *= __uint_as_float(z.y & 0xffff0000u);
                    b[0] *= __uint_as_float(z.z << 16); b[1] *= __uint_as_float(z.z & 0xffff0000u); b[2] *= __uint_as_float(z.w << 16); b[3] *= __uint_as_float(z.w & 0xffff0000u);
                    *(u32x4*)(YB + off) = pack8(a, b); } }
            asm volatile("" ::: "memory");
        }
    }
};
template <int L> __device__ __forceinline__ void phase_fnet_mix(const Params& p, unsigned char* lds) {
    constexpr int M = L == 3 ? ML : MT;
    pg8::Gemm g{8192, 512, 512};
    SchedLin S; S.init(M, 4096, gridDim.x, blockIdx.x, true); S.A0 = (const char*)(p.ws + WS_TO); S.B0 = (const char*)(p.ws + WS_BMIX); S.sAm = (size_t)256 * 8192 * 2; S.sAn = 512 * 2; S.sBm = 0; S.sBn = 256 * 512 * 2;
    EpiMix E{(const bf16*)(p.ws + WS_ZB), (bf16*)(p.ws + WS_YB_F)};
    pg8::gemm_phase<EpiMix, SchedLin>((PG8_LAS unsigned char*)lds, g, S, E);
}

struct SchedAttnIn : pg8::StaticOrder {
    const char* HBp; const char* WINp;
    __device__ __forceinline__ const char* aptr(const Unit& u) const { return ((u.pn == 18 || u.pn == 19) ? WINp + (size_t)u.pn * (256 * 2048 * 2) : HBp + (size_t)u.pm * (256 * 2048 * 2)) + (size_t)u.roff * (2048 * 2); }
    __device__ __forceinline__ const char* bptr(const Unit& u) const { return (u.pn == 18 || u.pn == 19) ? HBp + (size_t)u.pm * (256 * 2048 * 2) : WINp + (size_t)u.pn * (256 * 2048 * 2); }
};
__device__ __forceinline__ u32x2 pack4(const pg8::f32x4& a) { u32x2 w; w.x = pg8::cvt_pk_bf16(a[0], a[1]); w.y = pg8::cvt_pk_bf16(a[2], a[3]); return w; }
struct EpiAttnIn {
    static constexpr bool PERM = false;
    unsigned char* ws;
    __device__ __forceinline__ void operator()(const pg8::f32x4 (&acc)[2][2][4][2], const Unit& u, int wr, int wc, int fr, int fq) const {
        { int t_ = tidx(); fr = t_ & 15; fq = (t_ >> 4) & 3; }
        if (u.pn < 18) {
            const bool isq = u.pn < 16; bf16* const O = isq ? (bf16*)(ws + WS_QB) : (bf16*)(ws + WS_KB); const int ldo = isq ? 4096 : 512; const int cb = (isq ? u.pn : u.pn - 16) * 256 + wc * 32 + 4 * fq;
            const float sc = isq ? 0.125f * 1.4426950408889634f : 1.f; const float* rope = (const float*)(ws + TAB_ROPE);
#pragma unroll
            for (int ai = 0; ai < 2; ++ai)
#pragma unroll
                for (int m = 0; m < 4; ++m) { if (ai >= u.na) break; const int row = u.pm * 256 + u.roff + ai * 128 + wr * 64 + m * 16 + fr;
                    pg8::f32x4 c4 = (pg8::f32x4){1.f, 1.f, 1.f, 1.f}, s4 = (pg8::f32x4){0.f, 0.f, 0.f, 0.f};
                    if (row < ML) { const int t = row & 8191, pos = (wc & 1) ? (t & 63) : (t >> 6); const pg8::f32x4 r0 = *(const pg8::f32x4*)(rope + 2 * (pos * 16 + 4 * fq)), r1 = *(const pg8::f32x4*)(rope + 2 * (pos * 16 + 4 * fq) + 4);
                        c4 = (pg8::f32x4){r0[0], r0[2], r1[0], r1[2]}; s4 = (pg8::f32x4){r0[1], r0[3], r1[1], r1[3]}; }
#pragma unroll
                    for (int bj = 0; bj < 2; ++bj) { const pg8::f32x4 x1 = acc[ai][bj][m][0], x2 = acc[ai][bj][m][1];
                        const pg8::f32x4 y1 = (x1 * c4 - x2 * s4) * sc, y2 = (x1 * s4 + x2 * c4) * sc; bf16* o = O + (size_t)row * ldo + cb + bj * 128;
                        *(u32x2*)o = pack4(y1); *(u32x2*)(o + 16) = pack4(y2); }
                    if (m == 3) asm volatile("" ::: "memory"); }
        } else if (u.pn < 20) {
#pragma unroll
            for (int ai = 0; ai < 2; ++ai)
#pragma unroll
                for (int m = 0; m < 4; ++m) { if (ai >= u.na) break; const int ch = (u.pn - 18) * 256 + u.roff + ai * 128 + wr * 64 + m * 16 + fr;
#pragma unroll
                    for (int bj = 0; bj < 2; ++bj)
#pragma unroll
                        for (int n = 0; n < 2; ++n) { const int tcol = bj * 128 + wc * 32 + n * 16 + 4 * fq; bf16* dst;
                            if (u.pm < 64) { const int tk = u.pm * 256 + tcol; dst = (bf16*)(ws + WS_VT) + ((size_t)((tk >> 13) * 512 + ch) * 8192 + (tk & 8191)); }
                            else dst = (bf16*)(ws + WS_VTC) + ((size_t)((u.pm - 64) * 512 + ch) * 256 + tcol);
                            *(u32x2*)dst = pack4(acc[ai][bj][m][n]); } }
        } else {
            bf16* const ZB = (bf16*)(ws + WS_ZA);
#pragma unroll
            for (int ai = 0; ai < 2; ++ai)
#pragma unroll
                for (int m = 0; m < 4; ++m) { if (ai >= u.na) break; const int row = u.pm * 256 + u.roff + ai * 128 + wr * 64 + m * 16 + fr;
#pragma unroll
                    for (int bj = 0; bj < 2; ++bj)
#pragma unroll
                        for (int n = 0; n < 2; ++n) { pg8::f32x4 a = acc[ai][bj][m][n];
#pragma unroll
                            for (int e = 0; e < 4; ++e) a[e] = silu_f(a[e]);
                            *(u32x2*)(ZB + (size_t)row * 4096 + (u.pn - 20) * 256 + bj * 128 + wc * 32 + n * 16 + 4 * fq) = pack4(a); } }
        }
    }
};
__device__ __forceinline__ void phase_inproj_attn(const Params& p, unsigned char* lds) {
    pg8::Gemm g{DM, DM, DM};
    SchedAttnIn S; S.init(MT, 9216, gridDim.x, blockIdx.x, true); S.HBp = (const char*)(p.ws + WS_HB); S.WINp = (const char*)(p.ws + WS_WIN);
    EpiAttnIn E{p.ws};
    pg8::gemm_phase<EpiAttnIn, SchedAttnIn>((PG8_LAS unsigned char*)lds, g, S, E);
}
typedef short bf16x8_t __attribute__((ext_vector_type(8)));
typedef float f32x16 __attribute__((ext_vector_type(16)));
#define MFMA32(a, b, c) __builtin_amdgcn_mfma_f32_32x32x16_bf16((a), (b), (c), 0, 0, 0)
__device__ __forceinline__ bf16x8_t pack_step(const f32x16& x, int s) {
    u32x4 q;
    asm volatile("s_nop 3\n\tv_cvt_pk_bf16_f32 %0, %4, %5\n\tv_cvt_pk_bf16_f32 %1, %6, %7\n\tv_cvt_pk_bf16_f32 %2, %8, %9\n\tv_cvt_pk_bf16_f32 %3, %10, %11\n\ts_nop 1"
                 : "=&v"(q[0]), "=&v"(q[1]), "=&v"(q[2]), "=&v"(q[3])
                 : "v"(x[8 * s]), "v"(x[8 * s + 1]), "v"(x[8 * s + 2]), "v"(x[8 * s + 3]), "v"(x[8 * s + 4]), "v"(x[8 * s + 5]), "v"(x[8 * s + 6]), "v"(x[8 * s + 7]));
    return __builtin_bit_cast(bf16x8_t, q);
}
__device__ __forceinline__ void phase_attn(const Params& p, unsigned char* lds) {
    const int tid = tidx(), lane = tid & 63, wave = __builtin_amdgcn_readfirstlane(tid >> 6), r = lane & 31, h = lane >> 5;
    const bf16* QB = (const bf16*)(p.ws + WS_QB); const bf16* KB = (const bf16*)(p.ws + WS_KB); const bf16* VT = (const bf16*)(p.ws + WS_VT); const bf16* VTC = (const bf16*)(p.ws + WS_VTC);
    const bf16* ZB = (const bf16*)(p.ws + WS_ZA); bf16* YB = (bf16*)(p.ws + WS_YB); const float* sink = p.in[11];
    const int sk = tid >> 3, sp = tid & 7;
    constexpr int BUF = 18432, VOFF = 9216, RS = 144;
    for (int item = blockIdx.x; item < 2112; item += gridDim.x) {
        int b, kvh, q0, qrow0, cfirst, nw;
        if (item < 2048) { b = item >> 10; kvh = (item >> 7) & 7; q0 = (item & 127) * 64; qrow0 = b * 8192 + q0;
            cfirst = q0 < 128 ? (128 - q0) >> 6 : 0; const int clast = q0 > 8000 ? (8256 - q0) >> 6 : 4; nw = clast - cfirst + 1; }
        else { const int i2 = item - 2048; b = i2 >> 5; kvh = (i2 >> 2) & 7; q0 = (i2 & 3) * 64; qrow0 = ML + b * 256 + q0; cfirst = 0; nw = 0; }
        const int nch = nw + 4, hq = kvh * 8 + wave;
        bf16x8_t Qf[2][4];
#pragma unroll
        for (int sb = 0; sb < 2; ++sb)
#pragma unroll
            for (int st = 0; st < 4; ++st) Qf[sb][st] = *(const bf16x8_t*)((const char*)QB + (size_t)(unsigned)(((qrow0 + sb * 32 + r) * 4096 + hq * 64 + 16 * st + 8 * h) * 2));
        float mrun[2], lrun[2]; f32x16 O[2][2];
#pragma unroll
        for (int sb = 0; sb < 2; ++sb) { mrun[sb] = sink[hq] * 1.4426950408889634f; lrun[sb] = h == 0 ? 1.f : 0.f;
#pragma unroll
            for (int dt = 0; dt < 2; ++dt)
#pragma unroll
                for (int i = 0; i < 16; ++i) O[sb][dt][i] = 0.f; }
        u32x4 kreg, vreg;
#define ATT_SRC(j, kp_, vp_) do { if ((j) < nw) { const int kpos0_ = q0 - 128 + 64 * (cfirst + (j)); kp_ = (const char*)KB + (size_t)(unsigned)((((b * 8192 + kpos0_ + sk) * 512) + kvh * 64 + sp * 8) * 2); vp_ = (const char*)VT + (size_t)(unsigned)((((b * 512 + kvh * 64 + sk) * 8192) + kpos0_ + sp * 8) * 2); } \
        else { const int kc = 64 * ((j) - nw); kp_ = (const char*)KB + (size_t)(unsigned)((((ML + b * 256 + kc + sk) * 512) + kvh * 64 + sp * 8) * 2); vp_ = (const char*)VTC + (size_t)(unsigned)((((b * 512 + kvh * 64 + sk) * 256) + kc + sp * 8) * 2); } } while (0)
        { const char* kp; const char* vp; ATT_SRC(0, kp, vp); kreg = *(const u32x4*)kp; vreg = *(const u32x4*)vp;
          *(u32x4*)(lds + sk * RS + sp * 16) = kreg; *(u32x4*)(lds + VOFF + sk * RS + sp * 16) = vreg; }
        __syncthreads();
        for (int j = 0; j < nch; ++j) {
            const bool more = j + 1 < nch;
            if (more) { const char* kp; const char* vp; ATT_SRC(j + 1, kp, vp); kreg = *(const u32x4*)kp; vreg = *(const u32x4*)vp; }
            const unsigned char* Kb = lds + (j & 1) * BUF; const unsigned char* Vb = Kb + VOFF;
            const int cw = cfirst + j; const bool mlo = (j < nw) && cw == 0, mhi = (j < nw) && cw == 4; const int kpos0 = q0 - 128 + 64 * cw;
            f32x16 sc[2][2];
#pragma unroll
            for (int sb = 0; sb < 2; ++sb) {
#pragma unroll
                for (int i = 0; i < 16; ++i) { sc[sb][0][i] = 0.f; sc[sb][1][i] = 0.f; }
#pragma unroll
                for (int st = 0; st < 4; ++st) { const bf16x8_t k0 = *(const bf16x8_t*)(Kb + r * RS + (16 * st + 8 * h) * 2), k1 = *(const bf16x8_t*)(Kb + (32 + r) * RS + (16 * st + 8 * h) * 2);
                    sc[sb][0] = MFMA32(k0, Qf[sb][st], sc[sb][0]); sc[sb][1] = MFMA32(k1, Qf[sb][st], sc[sb][1]); }
            }
#pragma unroll
            for (int sb = 0; sb < 2; ++sb) {
                f32x16& s0 = sc[sb][0]; f32x16& s1 = sc[sb][1];
                if (mlo || mhi) { const int qpos = q0 + sb * 32 + r, lo_t = mlo ? qpos - 128 : -(1 << 30), hi_t = mhi ? qpos + 128 : (1 << 30);
#pragma unroll
                    for (int i = 0; i < 16; ++i) { const int kp0 = kpos0 + (i & 3) + 8 * (i >> 2) + 4 * h, kp1 = kp0 + 32;
                        s0[i] = (kp0 < lo_t || kp0 > hi_t) ? -1e30f : s0[i]; s1[i] = (kp1 < lo_t || kp1 > hi_t) ? -1e30f : s1[i]; } }
                float mx = fmaxf(s0[0], s1[0]);
#pragma unroll
                for (int i = 1; i < 16; ++i) mx = fmaxf(mx, fmaxf(s0[i], s1[i]));
                mx = fmaxf(mx, __shfl_xor(mx, 32));
                const float mn = fmaxf(mrun[sb], mx), al = __builtin_amdgcn_exp2f(mrun[sb] - mn); mrun[sb] = mn;
                float rs = 0.f;
#pragma unroll
                for (int i = 0; i < 16; ++i) { s0[i] = __builtin_amdgcn_exp2f(s0[i] - mn); s1[i] = __builtin_amdgcn_exp2f(s1[i] - mn); rs += s0[i] + s1[i]; }
                lrun[sb] = lrun[sb] * al + rs;
#pragma unroll
                for (int dt = 0; dt < 2; ++dt)
#pragma unroll
                    for (int i = 0; i < 16; ++i) O[sb][dt][i] *= al;
#pragma unroll
                for (int kt = 0; kt < 2; ++kt)
#pragma unroll
                    for (int st = 0; st < 2; ++st) { const bf16x8_t pf = pack_step(kt ? s1 : s0, st);
#pragma unroll
                        for (int dt = 0; dt < 2; ++dt) { const unsigned char* va = Vb + (32 * dt + r) * RS + (32 * kt + 16 * st + 4 * h) * 2;
                            const u32x2 v0 = *(const u32x2*)va, v1 = *(const u32x2*)(va + 16); u32x4 vv; vv.x = v0.x; vv.y = v0.y; vv.z = v1.x; vv.w = v1.y;
                            O[sb][dt] = MFMA32(__builtin_bit_cast(bf16x8_t, vv), pf, O[sb][dt]); } }
            }
            if (more) { unsigned char* nb = lds + ((j + 1) & 1) * BUF; *(u32x4*)(nb + sk * RS + sp * 16) = kreg; *(u32x4*)(nb + VOFF + sk * RS + sp * 16) = vreg; }
            __syncthreads();
        }
#undef ATT_SRC
        u32x2 zv[2][2][4];
#pragma unroll
        for (int sb = 0; sb < 2; ++sb) { const unsigned rowoff = (unsigned)((qrow0 + sb * 32 + r) * 4096 + hq * 64);
#pragma unroll
            for (int dt = 0; dt < 2; ++dt)
#pragma unroll
                for (int g4 = 0; g4 < 4; ++g4) zv[sb][dt][g4] = *(const u32x2*)(ZB + (size_t)(rowoff + 32 * dt + 8 * g4 + 4 * h)); }
#pragma unroll
        for (int sb = 0; sb < 2; ++sb) { const float lt = lrun[sb] + __shfl_xor(lrun[sb], 32), il = __builtin_amdgcn_rcpf(lt); const unsigned rowoff = (unsigned)((qrow0 + sb * 32 + r) * 4096 + hq * 64);
#pragma unroll
            for (int dt = 0; dt < 2; ++dt)
#pragma unroll
                for (int g4 = 0; g4 < 4; ++g4) { const size_t off = (size_t)(rowoff + 32 * dt + 8 * g4 + 4 * h); const u32x2 z = zv[sb][dt][g4];
                    const float y0 = O[sb][dt][4 * g4 + 0] * il * __uint_as_float(z.x << 16), y1 = O[sb][dt][4 * g4 + 1] * il * __uint_as_float(z.x & 0xffff0000u);
                    const float y2 = O[sb][dt][4 * g4 + 2] * il * __uint_as_float(z.y << 16), y3 = O[sb][dt][4 * g4 + 3] * il * __uint_as_float(z.y & 0xffff0000u);
                    u32x2 w; w.x = pg8::cvt_pk_bf16(y0, y1); w.y = pg8::cvt_pk_bf16(y2, y3); *(u32x2*)(YB + off) = w; } }
    }
}

__device__ __forceinline__ float gelu_fast(float x) { const float u = x * (1.5957691216057308f + 0.07135481627159768f * x * x); return x * __builtin_amdgcn_rcpf(1.f + __builtin_amdgcn_exp2f(-1.4426950408889634f * u)); }
struct EpiGmlpIn {
    static constexpr bool PERM = true;
    unsigned char* ws;
    __device__ __forceinline__ void operator()(const pg8::f32x4 (&acc)[2][2][4][2], const Unit& u, int wr, int wc, int fr, int fq) const {
        { int t_ = tidx(); fr = t_ & 15; fq = (t_ >> 4) & 3; }
        const int kind = u.pn >> 4; bf16* const O = (bf16*)(ws + (kind == 0 ? WS_UG : (kind == 1 ? WS_VG : WS_ZG))); const int cb = (u.pn & 15) * 256 + wc * 32 + 8 * fq;
#pragma unroll
        for (int ai = 0; ai < 2; ++ai)
#pragma unroll
            for (int m = 0; m < 4; ++m) { if (ai >= u.na) break; const int row = u.pm * 256 + u.roff + ai * 128 + wr * 64 + m * 16 + fr; float s1 = 0.f, s2 = 0.f;
#pragma unroll
                for (int bj = 0; bj < 2; ++bj) { pg8::f32x4 a = acc[ai][bj][m][0], b = acc[ai][bj][m][1];
                    if (kind == 2) {
#pragma unroll
                        for (int e = 0; e < 4; ++e) { a[e] = silu_f(a[e]); b[e] = silu_f(b[e]); } }
                    else {
#pragma unroll
                        for (int e = 0; e < 4; ++e) { a[e] = gelu_fast(a[e]); b[e] = gelu_fast(b[e]); s1 += a[e] + b[e]; s2 += a[e] * a[e] + b[e] * b[e]; } }
                    *(u32x4*)(O + (size_t)row * 4096 + cb + bj * 128) = pack8(a, b); }
                if (kind == 1) { s1 += __shfl_xor(s1, 16); s1 += __shfl_xor(s1, 32); s2 += __shfl_xor(s2, 16); s2 += __shfl_xor(s2, 32);
                    if (fq == 0) { float* st = (float*)(ws + WS_STAT) + ((size_t)row * 64 + (u.pn - 16) * 4 + wc) * 2; st[0] = s1; st[1] = s2; } } }
    }
};
__device__ __forceinline__ void phase_inproj_gmlp(const Params& p, unsigned char* lds) {
    pg8::Gemm g{DM, DM, DM};
    SchedLin S; S.init(MT, 12288, gridDim.x, blockIdx.x, true); S.plain(p.ws + WS_HB, DM, p.ws + WS_WIN, DM);
    EpiGmlpIn E{p.ws};
    pg8::gemm_phase<EpiGmlpIn, SchedLin>((PG8_LAS unsigned char*)lds, g, S, E);
}
template <int NTOK> __device__ __forceinline__ void gmlp_ln_item(const Params& p, unsigned char* lds, int chunk, int toff) {
    const int tid = tidx();
    float* mr = (float*)lds;
    bf16* T = (bf16*)(lds + 1024);
    const bf16* VG = (const bf16*)(p.ws + WS_VG); bf16* VT2 = (bf16*)(p.ws + WS_VT2); const float* STAT = (const float*)(p.ws + WS_STAT);
    const float* lg = p.in[15]; const float* lb = p.in[16];
    const int row0 = chunk * 128 + toff;
    __syncthreads();
    { const int t = tid >> 3, q = tid & 7;
      if (t < NTOK) { const float* st = STAT + ((size_t)(row0 + t) * 64 + q * 8) * 2; float s1 = 0.f, s2 = 0.f;
#pragma unroll
          for (int e = 0; e < 8; ++e) { s1 += st[2 * e]; s2 += st[2 * e + 1]; }
          s1 += __shfl_xor(s1, 1); s1 += __shfl_xor(s1, 2); s1 += __shfl_xor(s1, 4); s2 += __shfl_xor(s2, 1); s2 += __shfl_xor(s2, 2); s2 += __shfl_xor(s2, 4);
          if (q == 0) { const float mu = s1 * (1.f / 4096.f); const float var = fmaxf(s2 * (1.f / 4096.f) - mu * mu, 0.f); mr[2 * t] = mu; mr[2 * t + 1] = rsqrtf(var + EPS); } } }
    __syncthreads();
    u32x4 wv[NTOK / 16], wn[NTOK / 16];
#pragma unroll
    for (int i = 0; i < NTOK / 16; ++i) { const int pc = tid + i * NTHR, t = pc >> 5, c8 = (pc & 31) * 8; wv[i] = *(const u32x4*)(VG + (size_t)(row0 + t) * 4096 + c8); }
    for (int g = 0; g < 16; ++g) {
        if (g < 15) {
#pragma unroll
            for (int i = 0; i < NTOK / 16; ++i) { const int pc = tid + i * NTHR, t = pc >> 5, c8 = (pc & 31) * 8; wn[i] = *(const u32x4*)(VG + (size_t)(row0 + t) * 4096 + (g + 1) * 256 + c8); } }
#pragma unroll
        for (int i = 0; i < NTOK / 16; ++i) { const int pc = tid + i * NTHR, t = pc >> 5, c8 = (pc & 31) * 8; const u32x4 w = wv[i];
            const float mu = mr[2 * t], rs = mr[2 * t + 1]; const f32x4 g0 = *(const f32x4*)(lg + g * 256 + c8), g1 = *(const f32x4*)(lg + g * 256 + c8 + 4), b0 = *(const f32x4*)(lb + g * 256 + c8), b1 = *(const f32x4*)(lb + g * 256 + c8 + 4);
            u32x4 o; o.x = pk2((__uint_as_float(w.x << 16) - mu) * rs * g0.x + b0.x, (__uint_as_float(w.x & 0xffff0000u) - mu) * rs * g0.y + b0.y);
            o.y = pk2((__uint_as_float(w.y << 16) - mu) * rs * g0.z + b0.z, (__uint_as_float(w.y & 0xffff0000u) - mu) * rs * g0.w + b0.w);
            o.z = pk2((__uint_as_float(w.z << 16) - mu) * rs * g1.x + b1.x, (__uint_as_float(w.z & 0xffff0000u) - mu) * rs * g1.y + b1.y);
            o.w = pk2((__uint_as_float(w.w << 16) - mu) * rs * g1.z + b1.z, (__uint_as_float(w.w & 0xffff0000u) - mu) * rs * g1.w + b1.w);
            *(u32x4*)(T + t * 264 + c8) = o; }
        __syncthreads();
        { const int c = tid >> 1, t0 = (tid & 1) * (NTOK / 2); bf16* dst = VT2 + ((size_t)(chunk * 4096 + g * 256 + c) * 128 + toff + t0);
#pragma unroll
          for (int q = 0; q < NTOK / 16; ++q) { u32x4 o; const bf16* sp = T + (t0 + 8 * q) * 264 + c;
              o.x = (unsigned)sp[0] | ((unsigned)sp[264] << 16); o.y = (unsigned)sp[2 * 264] | ((unsigned)sp[3 * 264] << 16); o.z = (unsigned)sp[4 * 264] | ((unsigned)sp[5 * 264] << 16); o.w = (unsigned)sp[6 * 264] | ((unsigned)sp[7 * 264] << 16);
              *(u32x4*)(dst + 8 * q) = o; } }
        __syncthreads();
#pragma unroll
        for (int i = 0; i < NTOK / 16; ++i) wv[i] = wn[i];
    }
}
__device__ __forceinline__ void phase_gmlp_ln(const Params& p, unsigned char* lds) {
    for (int item = blockIdx.x; item < 256 + 32; item += gridDim.x) {
        if (item < 256) gmlp_ln_item<64>(p, lds, item >> 1, (item & 1) * 64);
        else { const int i2 = item - 256; gmlp_ln_item<16>(p, lds, 128 + (i2 >> 3), (i2 & 7) * 16); }
    }
}
struct EpiGmlpS {
    static constexpr bool PERM = true;
    unsigned char* ws; const float* bs;
    __device__ __forceinline__ void operator()(const pg8::f32x4 (&acc)[2][2][4][2], const Unit& u, int wr, int wc, int fr, int fq) const {
        { int t_ = tidx(); fr = t_ & 15; fq = (t_ >> 4) & 3; }
        bf16* const UG = (bf16*)(ws + WS_UG); const bf16* const ZG = (const bf16*)(ws + WS_ZG);
        u32x4 uv[4][2], zv[4][2]; float bias[4];
#pragma unroll
        for (int m = 0; m < 4; ++m) { const int sl = wr * 64 + m * 16 + fr; bias[m] = bs[u.pn * 128 + sl];
#pragma unroll
            for (int bj = 0; bj < 2; ++bj) { const size_t off = (size_t)(u.pm * 128 + sl) * 4096 + u.pn * 256 + bj * 128 + wc * 32 + 8 * fq; uv[m][bj] = *(const u32x4*)(UG + off); zv[m][bj] = *(const u32x4*)(ZG + off); } }
#pragma unroll
        for (int m = 0; m < 4; ++m) { const int sl = wr * 64 + m * 16 + fr;
#pragma unroll
            for (int bj = 0; bj < 2; ++bj) { const size_t off = (size_t)(u.pm * 128 + sl) * 4096 + u.pn * 256 + bj * 128 + wc * 32 + 8 * fq;
                const u32x4 uu = uv[m][bj], zz = zv[m][bj]; pg8::f32x4 a = acc[0][bj][m][0] + bias[m], b = acc[0][bj][m][1] + bias[m];
                a[0] *= __uint_as_float(uu.x << 16) * __uint_as_float(zz.x << 16); a[1] *= __uint_as_float(uu.x & 0xffff0000u) * __uint_as_float(zz.x & 0xffff0000u);
                a[2] *= __uint_as_float(uu.y << 16) * __uint_as_float(zz.y << 16); a[3] *= __uint_as_float(uu.y & 0xffff0000u) * __uint_as_float(zz.y & 0xffff0000u);
                b[0] *= __uint_as_float(uu.z << 16) * __uint_as_float(zz.z << 16); b[1] *= __uint_as_float(uu.z & 0xffff0000u) * __uint_as_float(zz.z & 0xffff0000u);
                b[2] *= __uint_as_float(uu.w << 16) * __uint_as_float(zz.w << 16); b[3] *= __uint_as_float(uu.w & 0xffff0000u) * __uint_as_float(zz.w & 0xffff0000u);
                *(u32x4*)(UG + off) = pack8(a, b); } }
    }
};
__device__ __forceinline__ void phase_gmlp_spatial(const Params& p, unsigned char* lds) {
    pg8::Gemm g{128, 128, 128};
    SchedLin S; S.init(132 * 256, 4096, gridDim.x, blockIdx.x); S.A0 = (const char*)(p.ws + WS_WSB); S.sAm = 0; S.sAn = 128 * 128 * 2; S.B0 = (const char*)(p.ws + WS_VT2); S.sBm = (size_t)4096 * 128 * 2; S.sBn = 256 * 128 * 2;
    EpiGmlpS E{p.ws, p.in[14]};
    pg8::gemm_phase<EpiGmlpS, SchedLin, true>((PG8_LAS unsigned char*)lds, g, S, E);
}

__device__ __forceinline__ void phase_final(const Params& p) {
    const int lane = tidx() & 63, gw = blockIdx.x * NWAVES + (tidx() >> 6), NGW = gridDim.x * NWAVES;
    const float* gvec = p.in[17];
    f32x4 x[8], xn[8];
    int row = gw;
    if (row < ML) {
#pragma unroll
        for (int j = 0; j < 8; ++j) x[j] = *(const f32x4*)(p.out + (size_t)row * DM + 4 * lane + 256 * j); }
    for (; row < ML; row += NGW) {
        const int rn = row + NGW;
        if (rn < ML) {
#pragma unroll
            for (int j = 0; j < 8; ++j) xn[j] = *(const f32x4*)(p.out + (size_t)rn * DM + 4 * lane + 256 * j); }
        float* xr = p.out + (size_t)row * DM; float s = 0.f;
#pragma unroll
        for (int j = 0; j < 8; ++j) s += (x[j].x * x[j].x + x[j].y * x[j].y) + (x[j].z * x[j].z + x[j].w * x[j].w);
        const float rstd = rsqrtf(wave_sum(s) * (1.f / DM) + EPS);
#pragma unroll
        for (int j = 0; j < 8; ++j) { const int c0 = 4 * lane + 256 * j; const f32x4 g4 = *(const f32x4*)(gvec + c0); *(f32x4*)(xr + c0) = x[j] * rstd * g4; }
#pragma unroll
        for (int j = 0; j < 8; ++j) x[j] = xn[j];
    }
}

#define XB_TMO      128
#define XB_XCNT(j)  (256  + 64 * (j))
#define XB_XSUB(j)  (1280 + 64 * (j))
#define XB_XGEN(j)  (2304 + 64 * (j))
#define XB_TOP      3328
#define XB_TOPGEN   3392
#define XCD_BAR_WORDS 3456
#define XB_SPIN_CAP (1u << 22)
__device__ __forceinline__ unsigned xb_ld(unsigned* p)              { return __hip_atomic_load(p, __ATOMIC_RELAXED, __HIP_MEMORY_SCOPE_AGENT); }
__device__ __forceinline__ unsigned xb_add(unsigned* p, unsigned v) { return __hip_atomic_fetch_add(p, v, __ATOMIC_RELAXED, __HIP_MEMORY_SCOPE_AGENT); }
__device__ __forceinline__ unsigned xb_xcc_id() { return (unsigned)__builtin_amdgcn_s_getreg((3 << 11) | 20) & 0xFu; }
#define XB_SPIN(cond, bar) do { unsigned _sp = 0; while (cond) { __builtin_amdgcn_s_sleep(1); \
    if ((++_sp & 255u) == 0u) { if (xb_ld(&(bar)[XB_TMO])) break; if (_sp > XB_SPIN_CAP) { atomicAdd(&(bar)[XB_TMO], 1u); break; } } } } while (0)
struct XcdBarrier { unsigned* bar; unsigned x; volatile __attribute__((address_space(3))) unsigned* st; };
__device__ __forceinline__ XcdBarrier xcd_barrier_post(unsigned* bar, volatile __attribute__((address_space(3))) unsigned* st) {
    XcdBarrier b; b.bar = bar; b.x = xb_xcc_id(); b.st = st;
    if (threadIdx.x == 0) (void)xb_add(&bar[XB_XCNT(b.x)], 1u);
    return b;
}
__device__ __forceinline__ void xcd_barrier_complete(unsigned* bar, unsigned x, unsigned& nloc, unsigned& nx) {
    const unsigned G = gridDim.x * gridDim.y * gridDim.z;
    unsigned sum, cnt, mine, sp = 0u;
    for (;;) {
        sum = 0u; cnt = 0u; mine = 0u;
#pragma unroll
        for (unsigned j = 0; j < 16; ++j) { const unsigned c = xb_ld(&bar[XB_XCNT(j)]); sum += c; cnt += (c > 0u) ? 1u : 0u; mine = (j == x) ? c : mine; }
        if (sum == G) break;
        __builtin_amdgcn_s_sleep(1);
        if ((++sp & 255u) == 0u) { if (xb_ld(&bar[XB_TMO])) break; if (sp > XB_SPIN_CAP) { atomicAdd(&bar[XB_TMO], 1u); break; } }
    }
    nloc = mine > 0u ? mine : 1u; nx = cnt > 0u ? cnt : 1u;
}
__device__ __forceinline__ void xcd_barrier(const XcdBarrier& b) {
    asm volatile("s_waitcnt vmcnt(0)" ::: "memory");
    __syncthreads();
    if (threadIdx.x == 0) {
        unsigned* bar = b.bar;
        __builtin_amdgcn_s_waitcnt(0);
        unsigned nloc = b.st[0], nx = b.st[1];
        if (nloc == 0u) { xcd_barrier_complete(bar, b.x, nloc, nx); b.st[0] = nloc; b.st[1] = nx; }
        const unsigned old = xb_add(&bar[XB_XSUB(b.x)], 1u);
        const unsigned gen = old / nloc;
        if (old + 1u == (gen + 1u) * nloc) {
            __builtin_amdgcn_fence(__ATOMIC_RELEASE, "agent");
            asm volatile("s_waitcnt vmcnt(0)" ::: "memory");
            const unsigned og = xb_add(&bar[XB_TOP], 1u);
            const unsigned tg = og / nx;
            if (og + 1u == (tg + 1u) * nx) xb_add(&bar[XB_TOPGEN], 1u);
            else XB_SPIN(xb_ld(&bar[XB_TOPGEN]) == tg, bar);
            __builtin_amdgcn_fence(__ATOMIC_ACQUIRE, "agent");
            xb_add(&bar[XB_XGEN(b.x)], 1u);
            asm volatile("s_waitcnt vmcnt(0)" ::: "memory");
        } else {
            XB_SPIN(xb_ld(&bar[XB_XGEN(b.x)]) == gen, bar);
            __builtin_amdgcn_fence(__ATOMIC_ACQUIRE, "agent");
            asm volatile("s_waitcnt vmcnt(0)" ::: "memory");
        }
    }
    __syncthreads();
}

constexpr int NPH = 23;
__global__ void __launch_bounds__(NTHR, 2) fwd(Params p) {
    extern __shared__ __attribute__((aligned(16))) unsigned char lds[];
    cg::grid_group grid = cg::this_grid();
    const int lo = p.ph_lo, hi = p.ph_hi;
    volatile __attribute__((address_space(3))) unsigned* bst = (volatile __attribute__((address_space(3))) unsigned*)((__attribute__((address_space(3))) unsigned char*)lds + 131072 + 2048);
    if (threadIdx.x < 2) bst[threadIdx.x] = 0u;
    __syncthreads();
    const XcdBarrier xbar = xcd_barrier_post((unsigned*)(p.ws + WS_BAR), bst);
    if (hi > 1000) grid.sync();
#define PHASE(k, ...) if (lo <= (k) && (k) < hi) { __VA_ARGS__; if ((k) + 1 < hi) xcd_barrier(xbar); }
    PHASE(0, phase0(p, lds))
    PHASE(1, phase_prep<0>(p, lds))
    PHASE(2, phase_inproj_fnet<0>(p, lds))
    PHASE(3, phase_fnet_a(p, true, lds))
    PHASE(4, phase_fnet_c(p, lds))
    PHASE(5, phase_fnet_mix<0>(p, lds))
    PHASE(6, phase_outproj<0>(p, lds))
    PHASE(7, phase_prep<1>(p, lds))
    PHASE(8, phase_inproj_attn(p, lds))
    PHASE(9, phase_attn(p, lds))
    PHASE(10, phase_outproj<1>(p, lds))
    PHASE(11, phase_prep<2>(p, lds))
    PHASE(12, phase_inproj_gmlp(p, lds))
    PHASE(13, phase_gmlp_ln(p, lds))
    PHASE(14, phase_gmlp_spatial(p, lds))
    PHASE(15, phase_outproj<2>(p, lds))
    PHASE(16, phase_prep<3>(p, lds))
    PHASE(17, phase_inproj_fnet<3>(p, lds))
    PHASE(18, phase_fnet_a(p, false, lds))
    PHASE(19, phase_fnet_c(p, lds))
    PHASE(20, phase_fnet_mix<3>(p, lds))
    PHASE(21, phase_outproj<3>(p, lds))
    PHASE(22, phase_final(p))
#undef PHASE
}

extern "C" void kernel_launch(void* const* d_in, const int* in_sizes, int n_in, void* d_out, int out_size, void* d_ws, size_t ws_size, hipStream_t stream) {
    static int grid = 0;
    if (grid == 0) {
        int dev = 0, cus = 0, per_cu = 0;
        (void)hipGetDevice(&dev); (void)hipDeviceGetAttribute(&cus, hipDeviceAttributeMultiprocessorCount, dev);
        (void)hipFuncSetAttribute((const void*)fwd, hipFuncAttributeMaxDynamicSharedMemorySize, LDS_BYTES);
        (void)hipOccupancyMaxActiveBlocksPerMultiprocessor(&per_cu, (const void*)fwd, NTHR, LDS_BYTES);
        if (per_cu < 1) { fprintf(stderr, "kernel_launch: occupancy query says %d blocks per CU\n", per_cu); per_cu = 1; }
        (void)hipGetLastError();
        grid = cus;
        if (n_in != 18 || ws_size < WS_END) fprintf(stderr, "kernel_launch: unexpected n_in %d / ws_size %zu\n", n_in, ws_size);
    }
    (void)hipMemsetAsync((char*)d_ws + WS_BAR, 0, XCD_BAR_WORDS * 4, stream);
    Params p{};
    for (int i = 0; i < 18; ++i) p.in[i] = (const float*)d_in[i];
    p.out = (float*)d_out; p.ws = (unsigned char*)d_ws;
#if MK_COOP
    p.ph_lo = 0; p.ph_hi = NPH;
    void* args[] = {&p};
    hipError_t e = hipLaunchCooperativeKernel((const void*)fwd, dim3(grid), dim3(NTHR), args, LDS_BYTES, stream);
    if (e != hipSuccess) fprintf(stderr, "cooperative launch failed: %s (grid %d)\n", hipGetErrorString(e), grid);
#else
    for (int ph = 0; ph < NPH; ++ph) { p.ph_lo = ph; p.ph_hi = ph + 1; hipLaunchKernelGGL(fwd, dim3(grid), dim3(NTHR), LDS_BYTES, stream, p); }
#endif
}
```

```cpp
#include <hip/hip_runtime.h>
#include <hip/hip_cooperative_groups.h>
#include <cstdio>
#include <cstdint>
namespace cg = cooperative_groups;

#ifndef MK_COOP
#define MK_COOP 1
#endif

__device__ __forceinline__ int tidx() { int t = threadIdx.x; asm volatile("" : "+v"(t)); return t; }
namespace pg8 {
#define PG8_LAS __attribute__((address_space(3)))
typedef unsigned short bf16_t;
typedef short bf16x8 __attribute__((ext_vector_type(8)));
typedef float f32x4 __attribute__((ext_vector_type(4)));
typedef unsigned u32x4 __attribute__((ext_vector_type(4)));
constexpr int BM = 256, BK = 64, HALF = 128, HTB = HALF * BK * 2, STAGE_BYTES = 8 * HTB, NXCD = 8, WGM = 8;

__host__ __device__ __forceinline__ int lds_byte(int r, int c) { const int st = (r >> 4) * 2 + (c >> 5), rr = r & 15, cc = c & 31, ob = rr * 64 + cc * 2; return st * 1024 + (ob ^ (((ob >> 9) & 1) << 5)); }
__host__ __device__ __forceinline__ void stage_rc(int b, int& R, int& C) { const int st = b / 1024, sb = b % 1024, swz = sb ^ (((sb >> 9) & 1) << 5); R = (st >> 1) * 16 + swz / 64; C = (st & 1) * 32 + (swz % 64) / 2; }
__host__ __device__ __forceinline__ int perm32(int rho) { const int n = rho >> 4, i = rho & 15; return 8 * (i >> 2) + 4 * n + (i & 3); }

struct Unit { int pm, pn, na, roff; };
struct Gemm { int lda, ldb, K; };

struct StaticOrder {
    int nM, nN, nwg, G, c, nfull;
    __host__ __device__ void init(int M, int N, int G_, int c_, bool split = false) { nM = M / BM; nN = N / BM; nwg = nM * nN; G = G_; c = c_; nfull = nwg;
        if (split) { const int nf = (nwg / G) * G; if (2 * (nwg - nf) <= G) nfull = nf; } }
    __host__ __device__ void map(int wgid, Unit& u) const {
        { const int q = nwg / NXCD, r = nwg % NXCD, xcd = wgid % NXCD, off = wgid / NXCD; wgid = (xcd < r ? xcd * (q + 1) : r * (q + 1) + (xcd - r) * q) + off; }
        const int nig = WGM * nN, gid = wgid / nig, fm = gid * WGM, gsz = (nM - fm) < WGM ? (nM - fm) : WGM;
        u.pm = fm + ((wgid % nig) % gsz); u.pn = (wgid % nig) / gsz; }
    __host__ __device__ bool next(int i, Unit& u) const {
        const long L = (long)i * G + c;
        if (L < nfull) { map((int)L, u); u.na = 2; u.roff = 0; return true; }
        const long h = L - nfull; if (h >= 2L * (nwg - nfull)) return false;
        map(nfull + (int)(h >> 1), u); u.na = 1; u.roff = (int)(h & 1) * HALF; return true;
    }
};

__device__ __forceinline__ unsigned cvt_pk_bf16(float lo, float hi) { unsigned r; asm volatile("v_cvt_pk_bf16_f32 %0, %1, %2" : "=v"(r) : "v"(lo), "v"(hi)); return r; }

struct EpiResid {
    static constexpr bool PERM = false;
    const float* rl; float* xl; const float* gate;
    __device__ __forceinline__ void operator()(const f32x4 (&acc)[2][2][4][2], const Unit& u, int wr, int wc, int fr, int fq) const {
        { int t_ = tidx(); fr = t_ & 15; fq = (t_ >> 4) & 3; }
        const int col0 = u.pn * BM + wc * 32 + 4 * fq; const float* gp = gate + ((u.pm * BM) >> 13) * 6144 + 4096 + col0;
        f32x4 g4[2][2];
#pragma unroll
        for (int bj = 0; bj < 2; ++bj)
#pragma unroll
            for (int n = 0; n < 2; ++n) g4[bj][n] = *(const f32x4*)(gp + bj * HALF + n * 16);
#pragma unroll
        for (int ai = 0; ai < 2; ++ai) {
            f32x4 xv[4][2][2];
#pragma unroll
            for (int m = 0; m < 4; ++m) { const float* rr = rl + (size_t)(u.pm * BM + ai * HALF + wr * 64 + m * 16 + fr) * 2048 + col0;
#pragma unroll
                for (int bj = 0; bj < 2; ++bj)
#pragma unroll
                    for (int n = 0; n < 2; ++n) xv[m][bj][n] = *(const f32x4*)(rr + bj * HALF + n * 16); }
#pragma unroll
            for (int m = 0; m < 4; ++m) { float* xr = xl + (size_t)(u.pm * BM + ai * HALF + wr * 64 + m * 16 + fr) * 2048 + col0;
#pragma unroll
                for (int bj = 0; bj < 2; ++bj)
#pragma unroll
                    for (int n = 0; n < 2; ++n) *(f32x4*)(xr + bj * HALF + n * 16) = xv[m][bj][n] + g4[bj][n] * acc[ai][bj][m][n]; }
            asm volatile("" ::: "memory");
        }
    }
};

__device__ __forceinline__ const char* uni(const char* p) { const unsigned long long v = (unsigned long long)p; const unsigned lo = __builtin_amdgcn_readfirstlane((unsigned)v), hi = __builtin_amdgcn_readfirstlane((unsigned)(v >> 32)); return (const char*)(((unsigned long long)hi << 32) | lo); }
struct EpiPart {
    static constexpr bool PERM = false;
    float* part;
    __device__ __forceinline__ void operator()(const f32x4 (&acc)[2][2][4][2], const Unit& u, int wr, int wc, int fr, int fq) const {
        { int t_ = tidx(); fr = t_ & 15; fq = (t_ >> 4) & 3; }
        const int ks = u.pn >> 3, col0 = (u.pn & 7) * BM + wc * 32 + 4 * fq;
#pragma unroll
        for (int ai = 0; ai < 2; ++ai)
#pragma unroll
            for (int m = 0; m < 4; ++m) { float* o = part + ((size_t)(ks * 512 + u.pm * BM + ai * HALF + wr * 64 + m * 16 + fr)) * 2048 + col0;
#pragma unroll
                for (int bj = 0; bj < 2; ++bj)
#pragma unroll
                    for (int n = 0; n < 2; ++n) *(f32x4*)(o + bj * HALF + n * 16) = acc[ai][bj][m][n]; }
    }
};
template <class Epi, class Sched, bool HALFM = false>
__device__ __forceinline__ void gemm_phase(PG8_LAS unsigned char* lds, const Gemm g, const Sched& S, const Epi& E) {
    int tid_ = tidx();
    const int tid = tid_, wid = __builtin_amdgcn_readfirstlane(tid >> 6), lane = tid & 63, wr = wid >> 2, wc = wid & 3, fr = lane & 15, fq = lane >> 4;
    int K_ = g.K; asm volatile("" : "+s"(K_));
    const int K = K_, nt = K / BK;
    unsigned voffA[2], voffB[2];
#pragma unroll
    for (int i = 0; i < 2; ++i) { int R, C; stage_rc(tid * 16 + i * 8192, R, C); const int Rb = Epi::PERM ? ((R & ~31) + perm32(R & 31)) : R;
        voffA[i] = (unsigned)(R * g.lda + C) * 2u; voffB[i] = (unsigned)(Rb * g.ldb + C) * 2u; }
    const size_t kstep = (size_t)(BK * 2);
    const size_t hstepA = (size_t)HALF * g.lda * 2, hstepB = (size_t)HALF * g.ldb * 2;
    const unsigned ldsw = (unsigned)wid * 1024u;
    const int aoff = lds_byte(wr * 64 + fr, fq * 8), boff = lds_byte(wc * 32 + fr, fq * 8);
#define PG8_SA(b, h) (((b) * 2 + (h)) * HTB)
#define PG8_SB(b, h) ((4 + (b) * 2 + (h)) * HTB)
#define PG8_STAGE(bufoff, gbase, voff) do { _Pragma("unroll") for (int _i = 0; _i < 2; ++_i) \
        __builtin_amdgcn_global_load_lds((const unsigned*)((const char*)(gbase) + (voff)[_i]), (PG8_LAS unsigned*)(lds + (bufoff) + ldsw + _i * 8192), 16, 0, 0); } while (0)
#define PG8_LDA(dst, b, h) do { _Pragma("unroll") for (int m = 0; m < 4; ++m) _Pragma("unroll") for (int k = 0; k < 2; ++k) dst[m][k] = *(const PG8_LAS bf16x8*)(lds + PG8_SA(b, h) + aoff + m * 2048 + k * 1024); } while (0)
#define PG8_LDB(dst, b, h) do { _Pragma("unroll") for (int n = 0; n < 2; ++n) _Pragma("unroll") for (int k = 0; k < 2; ++k) dst[n][k] = *(const PG8_LAS bf16x8*)(lds + PG8_SB(b, h) + boff + n * 2048 + k * 1024); } while (0)
#define PG8_MMA(ai, bj, At, Bt) do { __builtin_amdgcn_s_setprio(2); _Pragma("unroll") for (int m = 0; m < 4; ++m) _Pragma("unroll") for (int n = 0; n < 2; ++n) _Pragma("unroll") for (int k = 0; k < 2; ++k) \
        acc[ai][bj][m][n] = __builtin_amdgcn_mfma_f32_16x16x32_bf16(Bt[n][k], At[m][k], acc[ai][bj][m][n], 0, 0, 0); __builtin_amdgcn_s_setprio(0); } while (0)
#define PG8_WAIT_V(n) asm volatile("s_waitcnt vmcnt(" #n ")" ::: "memory")
#define PG8_WAIT_L(n) asm volatile("s_waitcnt lgkmcnt(" #n ")" ::: "memory")
#define PG8_BAR __builtin_amdgcn_s_barrier()
#define PG8_SCHED __builtin_amdgcn_sched_barrier(0)
    Unit cur, nxt; int ui = 0;
    if (!S.next(0, cur)) return;
    f32x4 acc[2][2][4][2];
#pragma unroll
    for (int a = 0; a < 2; ++a)
#pragma unroll
        for (int b = 0; b < 2; ++b)
#pragma unroll
            for (int m = 0; m < 4; ++m)
#pragma unroll
                for (int n = 0; n < 2; ++n) acc[a][b][m][n] = (f32x4){0.f, 0.f, 0.f, 0.f};
    bf16x8 At[4][2], B0[2][2], B1[2][2];
    const char* cA = uni(S.aptr(cur)); const char* cB = uni(S.bptr(cur));
    {
        PG8_STAGE(PG8_SB(0, 0), cB, voffB); PG8_STAGE(PG8_SB(0, 1), cB + hstepB, voffB); PG8_STAGE(PG8_SA(0, 0), cA, voffA); PG8_STAGE(PG8_SA(0, 1), cA + hstepA, voffA);
        if (wr == 1) PG8_BAR;
        PG8_WAIT_V(2); PG8_BAR;
        PG8_STAGE(PG8_SB(1, 0), cB + kstep, voffB); PG8_STAGE(PG8_SA(1, 0), cA + kstep, voffA); PG8_STAGE(PG8_SB(1, 1), cB + hstepB + kstep, voffB);
        PG8_WAIT_V(6); PG8_BAR;
    }
    for (;;) {
        const bool has_next = S.next(ui + 1, nxt);
        const char* nA = has_next ? uni(S.aptr(nxt)) : cA; const char* nB = has_next ? uni(S.bptr(nxt)) : cB;
        for (int t = 0; t < nt; t += 2) {
            const bool last = (t == nt - 2);
            const char* a1 = cA + (size_t)(t + 1) * kstep;
            const char* a2 = last ? nA : cA + (size_t)(t + 2) * kstep; const char* b2 = last ? nB : cB + (size_t)(t + 2) * kstep;
            const char* a3 = a2 + kstep; const char* b3 = b2 + kstep;
            PG8_LDB(B0, 0, 0); PG8_LDB(B1, 0, 1); PG8_SCHED; PG8_LDA(At, 0, 0); PG8_STAGE(PG8_SA(1, 1), a1 + hstepA, voffA);
            PG8_WAIT_V(8); PG8_WAIT_L(0); PG8_BAR; PG8_MMA(0, 0, At, B0); PG8_MMA(0, 1, At, B1); PG8_BAR; PG8_SCHED;
            PG8_LDA(At, 0, 1); PG8_STAGE(PG8_SB(0, 0), b2, voffB); PG8_STAGE(PG8_SB(0, 1), b2 + hstepB, voffB); PG8_STAGE(PG8_SA(0, 0), a2, voffA);
            PG8_WAIT_V(8); PG8_WAIT_L(0); PG8_BAR; if (HALFM ? false : cur.na == 2) { PG8_MMA(1, 0, At, B0); PG8_MMA(1, 1, At, B1); } PG8_BAR; PG8_SCHED;
            PG8_LDB(B0, 1, 0); PG8_LDB(B1, 1, 1); PG8_SCHED; PG8_LDA(At, 1, 0); PG8_STAGE(PG8_SA(0, 1), a2 + hstepA, voffA);
            PG8_WAIT_V(8); PG8_WAIT_L(0); PG8_BAR; PG8_MMA(0, 0, At, B0); PG8_MMA(0, 1, At, B1); PG8_BAR; PG8_SCHED;
            PG8_LDA(At, 1, 1); PG8_STAGE(PG8_SB(1, 0), b3, voffB); PG8_STAGE(PG8_SB(1, 1), b3 + hstepB, voffB); PG8_STAGE(PG8_SA(1, 0), a3, voffA);
            PG8_WAIT_V(8); PG8_WAIT_L(0); PG8_BAR; if (HALFM ? false : cur.na == 2) { PG8_MMA(1, 0, At, B0); PG8_MMA(1, 1, At, B1); } PG8_BAR; PG8_SCHED;
        }
        if (wr == 0) PG8_BAR;
        E(acc, cur, wr, wc, fr, fq);
        if (!has_next) break;
#pragma unroll
        for (int a = 0; a < 2; ++a)
#pragma unroll
            for (int b = 0; b < 2; ++b)
#pragma unroll
                for (int m = 0; m < 4; ++m)
#pragma unroll
                    for (int n = 0; n < 2; ++n) acc[a][b][m][n] = (f32x4){0.f, 0.f, 0.f, 0.f};
        cur = nxt; cA = nA; cB = nB; ++ui;
        if (wr == 1) PG8_BAR;
    }
    PG8_WAIT_V(0);
    PG8_BAR;
#undef PG8_SA
#undef PG8_SB
#undef PG8_STAGE
#undef PG8_LDA
#undef PG8_LDB
#undef PG8_MMA
#undef PG8_WAIT_V
#undef PG8_WAIT_L
#undef PG8_BAR
#undef PG8_SCHED
}
}

typedef unsigned short bf16;
typedef float f32x4 __attribute__((ext_vector_type(4)));
typedef unsigned u32x4 __attribute__((ext_vector_type(4)));
typedef unsigned u32x2 __attribute__((ext_vector_type(2)));
constexpr int DM = 2048, SEQ = 8192, ML = 16384, MC = 512, MT = ML + MC, DBR = 4096, CTXL = 256, DEPTH = 4;
constexpr int NTHR = 512, NWAVES = 8;
constexpr float EPS = 1e-6f;
constexpr size_t MiB = 1u << 20;
constexpr size_t WS_MOD = 0;
constexpr size_t WS_BAR = 512 * 1024;
constexpr size_t WS_XC = 1 * MiB;
constexpr size_t WS_TAB = 5 * MiB;
constexpr size_t TAB_ROPE = WS_TAB + 65536, TAB_DA = WS_TAB + 131072, TAB_CASPM = WS_TAB + 262144;
constexpr size_t WS_WIN = 8 * MiB;
constexpr size_t WS_WOUT = 56 * MiB;
constexpr size_t WS_BMIX = 72 * MiB;
constexpr size_t WS_HB = 76 * MiB;
constexpr size_t WS_PB = 142 * MiB;
constexpr size_t WS_YB = 538 * MiB;
constexpr size_t WS_QB = 142 * MiB;
constexpr size_t WS_KB = 274 * MiB;
constexpr size_t WS_VT = 291 * MiB;
constexpr size_t WS_VTC = 307 * MiB;
constexpr size_t WS_ZA = 308 * MiB;
constexpr size_t WS_UG = 142 * MiB;
constexpr size_t WS_VG = 274 * MiB;
constexpr size_t WS_ZG = 406 * MiB;
constexpr size_t WS_VT2 = 538 * MiB;
constexpr size_t WS_STAT = 670 * MiB;
constexpr size_t WS_WSB = 72 * MiB;
constexpr size_t WS_TO = 76 * MiB;
constexpr size_t WS_U1 = 142 * MiB;
constexpr size_t WS_UCT = 270 * MiB;
constexpr size_t WS_ZB = 340 * MiB;
constexpr size_t WS_YP = 472 * MiB;
constexpr size_t WS_YB_F = 472 * MiB;
constexpr size_t TAB_DC2 = 760 * MiB;
constexpr size_t WS_PART = 728 * MiB;
constexpr size_t WS_END = 768 * MiB;
static_assert(WS_YP + (size_t)256 * MiB <= WS_END && WS_YB + (size_t)MT * DBR * 2 <= WS_END, "ws map");
constexpr int LDS_BYTES = 135168;

struct Params { const float* in[18]; float* out; unsigned char* ws; int ph_lo, ph_hi; };

__device__ __forceinline__ float bf2f(bf16 h) { return __uint_as_float((unsigned)h << 16); }
__device__ __forceinline__ unsigned f2bf(float f) { unsigned u = __float_as_uint(f); return (u + 0x7fffu + ((u >> 16) & 1u)) >> 16; }
__device__ __forceinline__ unsigned pk2(float lo, float hi) { return f2bf(lo) | (f2bf(hi) << 16); }
__device__ __forceinline__ float silu_f(float x) { return x * __builtin_amdgcn_rcpf(1.f + __builtin_amdgcn_exp2f(-1.4426950408889634f * x)); }
__device__ __forceinline__ float wave_sum(float v) {
#pragma unroll
    for (int o = 1; o < 64; o <<= 1) v += __shfl_xor(v, o);
    return v;
}
#define LDS_WAIT() asm volatile("s_waitcnt lgkmcnt(0)" ::: "memory")

struct SchedLin : pg8::StaticOrder {
    const char* A0; const char* B0; size_t sAm, sAn, sBm, sBn;
    __device__ __forceinline__ const char* aptr(const pg8::Unit& u) const { return A0 + u.pm * sAm + u.pn * sAn + (size_t)u.roff * (sAm >> 8); }
    __device__ __forceinline__ const char* bptr(const pg8::Unit& u) const { return B0 + u.pm * sBm + u.pn * sBn; }
    __device__ __forceinline__ void plain(const void* A, int lda, const void* B, int ldb) { A0 = (const char*)A; B0 = (const char*)B; sAm = (size_t)256 * lda * 2; sAn = 0; sBm = 0; sBn = (size_t)256 * ldb * 2; }
};

__device__ __forceinline__ void phase0(const Params& p, unsigned char* lds) {
    const int tid = tidx(), lane = tid & 63, wave = tid >> 6, G = gridDim.x, bid = blockIdx.x;
    float* sv = (float*)lds;
    float* red = sv + 3 * 2048;
    const float* c = p.in[1]; const float* cctx = p.in[3];
    for (int i = tid; i < 3 * 2048; i += NTHR) { const float v = i < 4096 ? c[i] : cctx[i - 4096]; sv[i] = silu_f(v); }
    __syncthreads();
    float* mod = (float*)(p.ws + WS_MOD);
    const float* ada_w = p.in[5]; const float* ada_b = p.in[6];
    typedef float f32x2 __attribute__((ext_vector_type(2)));
    for (int it = bid; it < 4 * 48; it += G) {
        const int L = it / 48, jg = it % 48;
        const float* w = ada_w + (size_t)L * 2048 * 6144 + jg * 128 + 2 * lane;
        f32x2 a0 = {0.f, 0.f}, a1 = {0.f, 0.f}, a2 = {0.f, 0.f};
#pragma unroll 16
        for (int k = wave * 256; k < wave * 256 + 256; ++k) { const f32x2 wv = __builtin_nontemporal_load((const f32x2*)(w + (size_t)k * 6144)); a0 += sv[k] * wv; a1 += sv[2048 + k] * wv; a2 += sv[4096 + k] * wv; }
        f32x2* red2 = (f32x2*)red;
        red2[(wave * 3 + 0) * 64 + lane] = a0; red2[(wave * 3 + 1) * 64 + lane] = a1; red2[(wave * 3 + 2) * 64 + lane] = a2;
        __syncthreads();
        if (tid < 192) { const int v = tid >> 6, l = tid & 63; f32x2 s = {0.f, 0.f};
#pragma unroll
            for (int w8 = 0; w8 < 8; ++w8) s += red2[(w8 * 3 + v) * 64 + l];
            const f32x2 bb = *(const f32x2*)(ada_b + L * 6144 + jg * 128 + 2 * l);
            *(f32x2*)(mod + (size_t)(L * 3 + v) * 6144 + jg * 128 + 2 * l) = s + bb; }
        __syncthreads();
    }
    const int gt = bid * NTHR + tid, NT = G * NTHR;
    float* rope = (float*)(p.ws + TAB_ROPE);
    for (int j = gt; j < 128 * 16; j += NT) { const int pos = j >> 4, i = j & 15;
        const float inv = exp2f(-(float)i * (13.287712379549449f / 16.f)); const float ang = (float)pos * inv;
        double td = (double)ang * 0.15915494309189535; td -= floor(td); const float tf = (float)td;
        rope[2 * j] = __builtin_amdgcn_cosf(tf); rope[2 * j + 1] = __builtin_amdgcn_sinf(tf); }
    bf16* DA = (bf16*)(p.ws + TAB_DA); bf16* CPM = (bf16*)(p.ws + TAB_CASPM);
    for (int j = gt; j < 256 * 128; j += NT) { const int r = j >> 7, cc = j & 127;
        { const int k1 = r & 127; const float t = (float)((k1 * cc) & 127) * (1.f / 128.f); DA[j] = (bf16)f2bf(r < 128 ? __builtin_amdgcn_cosf(t) : -__builtin_amdgcn_sinf(t)); } }
    { bf16* DC2 = (bf16*)(p.ws + TAB_DC2);
      for (int j = gt; j < 129 * 128 * 128; j += NT) { const int cc = j & 127, r = (j >> 7) & 127, k1 = (j >> 14) & 127, ty = r >> 6, k2 = r & 63, n2 = cc >> 1, ri = cc & 1;
          const float t = (float)(((128 * k2 + k1) * n2) & 8191) * (1.f / 8192.f); const float c_ = __builtin_amdgcn_cosf(t), s_ = __builtin_amdgcn_sinf(t);
          DC2[j] = (bf16)f2bf(ty == 1 ? (ri == 0 ? c_ + s_ : s_ - c_) : (ri == 0 ? c_ - s_ : s_ + c_)); } }
    for (int j = gt; j < 512 * 256; j += NT) { const int r = j >> 8, n = j & 255, k = r & 255; const float t = (float)((k * n) & 255) * (1.f / 256.f); const float c_ = __builtin_amdgcn_cosf(t), s_ = __builtin_amdgcn_sinf(t);
        CPM[j] = (bf16)f2bf(r < 256 ? c_ - s_ : c_ + s_); }
}

__device__ __forceinline__ void transpose_all(const float* W, int ldw, int K, int ncols, bf16* WT, unsigned char* lds, int vb = -1, int nvb = 0) {
    const int tid = tidx(); float* tile = (float*)lds;
    const int nblk = ncols / 256, nitems = (K / 64) * nblk;
    if (vb < 0) { vb = blockIdx.x; nvb = gridDim.x; }
    f32x4 v[8];
    int it = vb;
    if (it < nitems) { const int k0 = 64 * (it / nblk), n0 = 256 * (it % nblk);
#pragma unroll
        for (int i = 0; i < 8; ++i) { const int pc = tid + i * NTHR, kk = pc >> 6, c4 = (pc & 63) * 4; v[i] = __builtin_nontemporal_load((const f32x4*)(W + (size_t)(k0 + kk) * ldw + n0 + c4)); } }
    for (; it < nitems; it += nvb) {
        const int kb = it / nblk, nb = it % nblk, k0 = 64 * kb, n0 = 256 * nb;
        __syncthreads();
#pragma unroll
        for (int i = 0; i < 8; ++i) { const int pc = tid + i * NTHR, kk = pc >> 6, c4 = (pc & 63) * 4; float* d = tile + kk * 257 + c4; d[0] = v[i].x; d[1] = v[i].y; d[2] = v[i].z; d[3] = v[i].w; }
        const int itn = it + nvb;
        if (itn < nitems) { const int k0n = 64 * (itn / nblk), n0n = 256 * (itn % nblk);
#pragma unroll
            for (int i = 0; i < 8; ++i) { const int pc = tid + i * NTHR, kk = pc >> 6, c4 = (pc & 63) * 4; v[i] = __builtin_nontemporal_load((const f32x4*)(W + (size_t)(k0n + kk) * ldw + n0n + c4)); } }
        __syncthreads();
        const int n = tid & 255, kh = (tid >> 8) * 32; const float* sp = tile + kh * 257 + n; bf16* o = WT + (size_t)(n0 + n) * K + k0 + kh;
#pragma unroll
        for (int q = 0; q < 4; ++q) { u32x4 w; w.x = pk2(sp[(8 * q) * 257], sp[(8 * q + 1) * 257]); w.y = pk2(sp[(8 * q + 2) * 257], sp[(8 * q + 3) * 257]); w.z = pk2(sp[(8 * q + 4) * 257], sp[(8 * q + 5) * 257]); w.w = pk2(sp[(8 * q + 6) * 257], sp[(8 * q + 7) * 257]);
            *(u32x4*)(o + 8 * q) = w; }
    }
    __syncthreads();
}
__device__ __forceinline__ void hartley_fold(const float* W  , bf16* WT, unsigned char* lds) {
    float* tile = (float*)lds;
    float* cas = tile + 64 * 257;
    const int tid = tidx();
    for (int it = blockIdx.x; it < 16 * 32; it += gridDim.x) {
        const int g = it >> 5, k0 = (it & 31) * 64;
        __syncthreads();
        { f32x4 v[8];
#pragma unroll
          for (int i = 0; i < 8; ++i) { const int pc = tid + i * NTHR, kk = pc >> 6, c4 = (pc & 63) * 4; v[i] = __builtin_nontemporal_load((const f32x4*)(W + (size_t)(k0 + kk) * 8192 + g * 256 + c4)); }
#pragma unroll
          for (int i = 0; i < 8; ++i) { const int pc = tid + i * NTHR, kk = pc >> 6, c4 = (pc & 63) * 4; float* d = tile + kk * 257 + c4; d[0] = v[i].x; d[1] = v[i].y; d[2] = v[i].z; d[3] = v[i].w; } }
        if (tid < 256) { const float t = (float)tid * (1.f / 256.f); cas[tid] = __builtin_amdgcn_cosf(t) + __builtin_amdgcn_sinf(t); }
        __syncthreads();
        const int l0 = tid & 63, kg = (tid >> 6) * 8;
        float acc[8][4];
#pragma unroll
        for (int kk = 0; kk < 8; ++kk)
#pragma unroll
            for (int jj = 0; jj < 4; ++jj) acc[kk][jj] = 0.f;
#pragma unroll 2
        for (int cc = 0; cc < 256; ++cc) { float w[4];
#pragma unroll
            for (int jj = 0; jj < 4; ++jj) w[jj] = cas[((l0 + 64 * jj) * cc) & 255];
#pragma unroll
            for (int kk = 0; kk < 8; ++kk) { const float tv = tile[(kg + kk) * 257 + cc];
#pragma unroll
                for (int jj = 0; jj < 4; ++jj) acc[kk][jj] += tv * w[jj]; } }
#pragma unroll
        for (int jj = 0; jj < 4; ++jj) { u32x4 w; w.x = pk2(acc[0][jj], acc[1][jj]); w.y = pk2(acc[2][jj], acc[3][jj]); w.z = pk2(acc[4][jj], acc[5][jj]); w.w = pk2(acc[6][jj], acc[7][jj]);
            *(u32x4*)(WT + (size_t)(g * 256 + l0 + 64 * jj) * 2048 + k0 + kg) = w; }
    }
    __syncthreads();
}
__device__ __forceinline__ void norm_rows(const Params& p, int L, int nrows, bool perm) {
    const int lane = tidx() & 63, gw = blockIdx.x * NWAVES + (tidx() >> 6), NGW = gridDim.x * NWAVES;
    const float* gvec = p.in[4] + L * 2048; const float* mod = (const float*)(p.ws + WS_MOD) + (size_t)L * 3 * 6144;
    bf16* HB = (bf16*)(p.ws + WS_HB);
    const float* xl = L == 0 ? p.in[0] : p.out; const float* xcx = L <= 1 ? p.in[2] : (const float*)(p.ws + WS_XC);
#define NR_SRC(r) ((r) < ML ? xl + (size_t)(r) * DM : xcx + (size_t)((r) - ML) * DM)
    f32x4 x[8], xn[8];
    int row = gw;
    if (row < nrows) { const float* xr = NR_SRC(row);
#pragma unroll
        for (int j = 0; j < 8; ++j) x[j] = *(const f32x4*)(xr + 4 * lane + 256 * j); }
    for (; row < nrows; row += NGW) {
        const int rn = row + NGW;
        if (rn < nrows) { const float* xr = NR_SRC(rn);
#pragma unroll
            for (int j = 0; j < 8; ++j) xn[j] = *(const f32x4*)(xr + 4 * lane + 256 * j); }
        const int v = row < ML ? (row >> 13) : 2; const float* sh = mod + v * 6144; const float* sc = sh + 2048;
        const int orow = (perm && row < ML) ? ((row & ~8191) + ((row & 63) << 7) + ((row & 8191) >> 6)) : row;
        bool emit = true;
        if (row >= ML && L >= 1) {
            const float* gp = mod - 3 * 6144 + 2 * 6144 + 4096; const float* pp = (const float*)(p.ws + WS_PART) + (size_t)(row - ML) * 2048; float* xw = (float*)(p.ws + WS_XC) + (size_t)(row - ML) * DM;
#pragma unroll
            for (int j = 0; j < 8; ++j) { const int c0 = 4 * lane + 256 * j; f32x4 a = *(const f32x4*)(pp + c0);
#pragma unroll
                for (int ks = 1; ks < 8; ++ks) a = a + *(const f32x4*)(pp + (size_t)ks * 512 * 2048 + c0);
                x[j] = x[j] + *(const f32x4*)(gp + c0) * a; *(f32x4*)(xw + c0) = x[j];
                asm volatile("" ::: "memory"); }
            emit = L != 3;
        }
        if (emit) {
            float s = 0.f;
#pragma unroll
            for (int j = 0; j < 8; ++j) s += (x[j].x * x[j].x + x[j].y * x[j].y) + (x[j].z * x[j].z + x[j].w * x[j].w);
            const float rstd = rsqrtf(wave_sum(s) * (1.f / DM) + EPS);
#pragma unroll
            for (int j = 0; j < 8; ++j) { const int c0 = 4 * lane + 256 * j; const f32x4 g4 = *(const f32x4*)(gvec + c0), s4 = *(const f32x4*)(sc + c0), h4 = *(const f32x4*)(sh + c0);
                const f32x4 y = x[j] * rstd * g4 * (1.f + s4) + h4; u32x2 w; w.x = pk2(y.x, y.y); w.y = pk2(y.z, y.w); *(u32x2*)(HB + (size_t)orow * DM + c0) = w; }
        }
#pragma unroll
        for (int j = 0; j < 8; ++j) x[j] = xn[j];
    }
#undef NR_SRC
}
template <int L> __device__ __forceinline__ void phase_prep(const Params& p, unsigned char* lds) {
    constexpr int kind = L % 3, j = L / 3;
    bf16* WIN = (bf16*)(p.ws + WS_WIN); bf16* WOUT = (bf16*)(p.ws + WS_WOUT);
    if (kind == 0) { const float* W = p.in[8] + (size_t)j * 2048 * 8192;
        hartley_fold(W, WIN, lds);
        transpose_all(W + 4096, 8192, 2048, 4096, WIN + (size_t)4096 * 2048, lds);
        { const float* wmix = p.in[9] + (size_t)j * 16 * 65536; bf16* BM = (bf16*)(p.ws + WS_BMIX);
          for (int base = blockIdx.x * NTHR + tidx(); base < 16 * 256 * 512; base += 8 * gridDim.x * NTHR) { float v[8];
#pragma unroll
              for (int e = 0; e < 8; ++e) { const int idx = base + e * gridDim.x * NTHR; const int jj = idx & 511, d = (idx >> 9) & 255, g = idx >> 17, l = jj < 256 ? jj : ((512 - jj) & 255);
                  v[e] = idx < 16 * 256 * 512 ? wmix[(size_t)g * 65536 + l * 256 + d] : 0.f; }
#pragma unroll
              for (int e = 0; e < 8; ++e) { const int idx = base + e * gridDim.x * NTHR; if (idx < 16 * 256 * 512) BM[idx] = (bf16)f2bf(v[e]); } } }
    } else if (kind == 1) transpose_all(p.in[10], 9216, 2048, 9216, WIN, lds);
    else { transpose_all(p.in[12], 12288, 2048, 12288, WIN, lds);
        bf16* WSB = (bf16*)(p.ws + WS_WSB); const float* wsp = p.in[13];
        for (int idx = blockIdx.x * NTHR + tidx(); idx < 16 * 128 * 128; idx += gridDim.x * NTHR) WSB[idx] = (bf16)f2bf(wsp[idx]); }
    transpose_all(p.in[7] + (size_t)L * 4096 * 2048, 2048, 4096, 2048, WOUT, lds);
    norm_rows(p, L, MT, kind == 0);
}

struct SchedCtxOut : pg8::StaticOrder {
    const char* A0; const char* B0;
    __device__ __forceinline__ const char* aptr(const pg8::Unit& u) const { return A0 + (size_t)u.pm * (256 * 4096 * 2) + (u.pn >> 3) * 1024; }
    __device__ __forceinline__ const char* bptr(const pg8::Unit& u) const { return B0 + (size_t)(u.pn & 7) * (256 * 4096 * 2) + (u.pn >> 3) * 1024; }
};
template <int L> __device__ __forceinline__ void phase_outproj(const Params& p, unsigned char* lds) {
    const unsigned char* Y = p.ws + (L % 3 == 0 ? WS_YB_F : (L % 3 == 1 ? WS_YB : WS_UG));
    { pg8::Gemm g{DBR, DBR, DBR};
      SchedLin S; S.init(ML, DM, gridDim.x, blockIdx.x); S.plain(Y, DBR, p.ws + WS_WOUT, DBR);
      pg8::EpiResid E{L == 0 ? p.in[0] : p.out, p.out, (const float*)(p.ws + WS_MOD) + (size_t)L * 3 * 6144};
      pg8::gemm_phase<pg8::EpiResid, SchedLin>((PG8_LAS unsigned char*)lds, g, S, E); }
    if (L < 3) {
        pg8::Gemm g{DBR, DBR, 512};
        SchedCtxOut S; S.init(MC, 64 * 256, gridDim.x, blockIdx.x); S.A0 = (const char*)(Y + (size_t)ML * DBR * 2); S.B0 = (const char*)(p.ws + WS_WOUT);
        pg8::EpiPart E{(float*)(p.ws + WS_PART)};
        pg8::gemm_phase<pg8::EpiPart, SchedCtxOut>((PG8_LAS unsigned char*)lds, g, S, E);
    }
}

using pg8::Unit;
__device__ __forceinline__ u32x4 pack8(const pg8::f32x4& a, const pg8::f32x4& b) { u32x4 w; w.x = pg8::cvt_pk_bf16(a[0], a[1]); w.y = pg8::cvt_pk_bf16(a[2], a[3]); w.z = pg8::cvt_pk_bf16(b[0], b[1]); w.w = pg8::cvt_pk_bf16(b[2], b[3]); return w; }
struct SchedFnetIn : pg8::StaticOrder {
    const char* HBp; const char* WINp;
    __device__ __forceinline__ const char* aptr(const Unit& u) const { return (u.pn < 16 ? WINp + (size_t)u.pn * (256 * 2048 * 2) : HBp + (size_t)u.pm * (256 * 2048 * 2)) + (size_t)u.roff * (2048 * 2); }
    __device__ __forceinline__ const char* bptr(const Unit& u) const { return u.pn < 16 ? HBp + (size_t)u.pm * (256 * 2048 * 2) : WINp + (size_t)u.pn * (256 * 2048 * 2); }
};
struct EpiFnetIn {
    static constexpr bool PERM = true;
    unsigned char* ws;
    __device__ __forceinline__ void operator()(const pg8::f32x4 (&acc)[2][2][4][2], const Unit& u, int wr, int wc, int fr, int fq) const {
        bf16* const U1 = (bf16*)(ws + WS_U1); bf16* const UCT = (bf16*)(ws + WS_UCT); bf16* const ZB = (bf16*)(ws + WS_ZB);
        { int t_ = tidx(); fr = t_ & 15; fq = (t_ >> 4) & 3; }
        if (u.pn < 16) {
#pragma unroll
            for (int ai = 0; ai < 2; ++ai)
#pragma unroll
                for (int m = 0; m < 4; ++m) { if (ai >= u.na) break; const int c = u.pn * 256 + u.roff + ai * 128 + wr * 64 + m * 16 + fr;
#pragma unroll
                    for (int bj = 0; bj < 2; ++bj) { const int tcol = bj * 128 + wc * 32 + 8 * fq; bf16* dst;
                        if (u.pm < 64) { const int rp = u.pm * 256 + tcol, b = rp >> 13, r = rp & 8191, n2 = r >> 7, n1 = r & 127; dst = U1 + ((size_t)(b * 4096 + c) * 64 + n2) * 128 + n1; }
                        else dst = UCT + ((size_t)((u.pm - 64) * 4096 + c) * 256 + tcol);
                        *(u32x4*)dst = pack8(acc[ai][bj][m][0], acc[ai][bj][m][1]); } }
        } else {
#pragma unroll
            for (int ai = 0; ai < 2; ++ai)
#pragma unroll
                for (int m = 0; m < 4; ++m) { if (ai >= u.na) break; const int rp = u.pm * 256 + u.roff + ai * 128 + wr * 64 + m * 16 + fr; int row = rp;
                    if (rp < ML) { const int r = rp & 8191; row = (rp & ~8191) + ((r & 127) << 6) + (r >> 7); }
#pragma unroll
                    for (int bj = 0; bj < 2; ++bj) { const int zc = (u.pn - 16) * 256 + bj * 128 + wc * 32 + 8 * fq; pg8::f32x4 a = acc[ai][bj][m][0], b = acc[ai][bj][m][1];
#pragma unroll
                        for (int e = 0; e < 4; ++e) { a[e] = silu_f(a[e]); b[e] = silu_f(b[e]); }
                        *(u32x4*)(ZB + (size_t)row * 4096 + zc) = pack8(a, b); } }
        }
    }
};
template <int L> __device__ __forceinline__ void phase_inproj_fnet(const Params& p, unsigned char* lds) {
    constexpr int M = L == 3 ? ML : MT;
    pg8::Gemm g{DM, DM, DM};
    SchedFnetIn S; S.init(M, 8192, gridDim.x, blockIdx.x, true); S.HBp = (const char*)(p.ws + WS_HB); S.WINp = (const char*)(p.ws + WS_WIN);
    EpiFnetIn E{p.ws};
    pg8::gemm_phase<EpiFnetIn, SchedFnetIn>((PG8_LAS unsigned char*)lds, g, S, E);
}
struct EpiStageA {
    static constexpr bool PERM = true;
    bf16* YP;
    __device__ __forceinline__ void operator()(const pg8::f32x4 (&acc)[2][2][4][2], const Unit& u, int wr, int wc, int fr, int fq) const {
        { int t_ = tidx(); fr = t_ & 15; fq = (t_ >> 4) & 3; }
#pragma unroll
        for (int m = 0; m < 4; ++m) { const int k1 = wr * 64 + m * 16 + fr;
#pragma unroll
            for (int bj = 0; bj < 2; ++bj) { const int idx = u.pn * 256 + bj * 128 + wc * 32 + 8 * fq, n2 = idx & 63, c = (idx >> 6) & 4095, b = idx >> 18;
                bf16* dst = YP + ((((size_t)(b * 128 + k1) * 4096 + c) * 64 + n2) << 1);
#pragma unroll
                for (int h = 0; h < 2; ++h) { const pg8::f32x4 re = acc[0][bj][m][h], im = acc[1][bj][m][h];
                    u32x4 w; w.x = pg8::cvt_pk_bf16(re[0], im[0]); w.y = pg8::cvt_pk_bf16(re[1], im[1]); w.z = pg8::cvt_pk_bf16(re[2], im[2]); w.w = pg8::cvt_pk_bf16(re[3], im[3]);
                    *(u32x4*)(dst + 8 * h) = w; } } }
    }
};
struct EpiCtxH {
    static constexpr bool PERM = true;
    bf16* TO;
    __device__ __forceinline__ void operator()(const pg8::f32x4 (&acc)[2][2][4][2], const Unit& u, int wr, int wc, int fr, int fq) const {
        { int t_ = tidx(); fr = t_ & 15; fq = (t_ >> 4) & 3; }
        const int b = u.pn >> 4, g = u.pn & 15;
#pragma unroll
        for (int ai = 0; ai < 2; ++ai)
#pragma unroll
            for (int m = 0; m < 4; ++m) { const int k = ai * 128 + wr * 64 + m * 16 + fr;
#pragma unroll
                for (int bj = 0; bj < 2; ++bj) { const int l = bj * 128 + wc * 32 + 8 * fq;
                    *(u32x4*)(TO + ((size_t)(ML + b * 256 + k) * 16 + g) * 512 + u.pm * 256 + l) = pack8(acc[ai][bj][m][0], acc[ai][bj][m][1]); } }
    }
};
__device__ __forceinline__ void phase_fnet_a(const Params& p, bool ctx, unsigned char* lds) {
    if (ctx) {
        pg8::Gemm g{256, 256, 256};
        SchedLin S; S.init(512, 8192, gridDim.x, blockIdx.x); S.A0 = (const char*)(p.ws + TAB_CASPM); S.B0 = (const char*)(p.ws + WS_UCT); S.sAm = 256 * 256 * 2; S.sAn = 0; S.sBm = 0; S.sBn = 256 * 256 * 2;
        EpiCtxH E{(bf16*)(p.ws + WS_TO)};
        pg8::gemm_phase<EpiCtxH, SchedLin>((PG8_LAS unsigned char*)lds, g, S, E);
    }
    pg8::Gemm g{128, 128, 128};
    SchedLin S; S.init(256, 2 * 4096 * 64, gridDim.x, blockIdx.x); S.A0 = (const char*)(p.ws + TAB_DA); S.B0 = (const char*)(p.ws + WS_U1); S.sAm = 0; S.sAn = 0; S.sBm = 0; S.sBn = 256 * 128 * 2;
    EpiStageA E{(bf16*)(p.ws + WS_YP)};
    pg8::gemm_phase<EpiStageA, SchedLin>((PG8_LAS unsigned char*)lds, g, S, E);
}
struct EpiStageC {
    static constexpr bool PERM = true;
    bf16* TO;
    __device__ __forceinline__ void operator()(const pg8::f32x4 (&acc)[2][2][4][2], const Unit& u, int wr, int wc, int fr, int fq) const {
        { int t_ = tidx(); fr = t_ & 15; fq = (t_ >> 4) & 3; }
        const int idx = u.pn * 256, g = (idx & 4095) >> 8, k1 = (idx >> 12) & 127, b = idx >> 19;
#pragma unroll
        for (int m = 0; m < 4; ++m) { const int k2 = m * 16 + fr; const size_t row = (size_t)b * 8192 + k1 + 128 * k2;
#pragma unroll
            for (int bj = 0; bj < 2; ++bj) { const int l = bj * 128 + wc * 32 + 8 * fq;
                *(u32x4*)(TO + (row * 16 + g) * 512 + wr * 256 + l) = pack8(acc[0][bj][m][0], acc[0][bj][m][1]); } }
    }
};
struct SchedStageC : pg8::StaticOrder {
    const char* A0; const char* B0; size_t sBn;
    __device__ __forceinline__ const char* aptr(const Unit& u) const { return A0 + (size_t)((u.pn >> 4) & 127) * (128 * 128 * 2); }
    __device__ __forceinline__ const char* bptr(const Unit& u) const { return B0 + u.pn * sBn; }
};
__device__ __forceinline__ void phase_fnet_c(const Params& p, unsigned char* lds) {
    pg8::Gemm g{128, 128, 128};
    SchedStageC S; S.init(256, 2 * 128 * 4096, gridDim.x, blockIdx.x); S.A0 = (const char*)(p.ws + TAB_DC2); S.B0 = (const char*)(p.ws + WS_YP); S.sBn = 256 * 128 * 2;
    EpiStageC E{(bf16*)(p.ws + WS_TO)};
    pg8::gemm_phase<EpiStageC, SchedStageC, true>((PG8_LAS unsigned char*)lds, g, S, E);
}
struct EpiMix {
    static constexpr bool PERM = true;
    const bf16* ZB; bf16* YB;
    __device__ __forceinline__ void operator()(const pg8::f32x4 (&acc)[2][2][4][2], const Unit& u, int wr, int wc, int fr, int fq) const {
        { int t_ = tidx(); fr = t_ & 15; fq = (t_ >> 4) & 3; }
#pragma unroll
        for (int ai = 0; ai < 2; ++ai) {
            if (ai >= u.na) break;
            u32x4 zv[4][2];
#pragma unroll
            for (int m = 0; m < 4; ++m)
#pragma unroll
                for (int bj = 0; bj < 2; ++bj) zv[m][bj] = *(const u32x4*)(ZB + (size_t)(u.pm * 256 + u.roff + ai * 128 + wr * 64 + m * 16 + fr) * 4096 + u.pn * 256 + bj * 128 + wc * 32 + 8 * fq);
#pragma unroll
            for (int m = 0; m < 4; ++m) { const int row = u.pm * 256 + u.roff + ai * 128 + wr * 64 + m * 16 + fr; const float sc = row < ML ? 0.5f * 6.9053396600248786e-4f : 0.5f / 256.f;
#pragma unroll
                for (int bj = 0; bj < 2; ++bj) { const size_t off = (size_t)row * 4096 + u.pn * 256 + bj * 128 + wc * 32 + 8 * fq;
                    const u32x4 z = zv[m][bj]; pg8::f32x4 a = acc[ai][bj][m][0] * sc, b = acc[ai][bj][m][1] * sc;
                    a[0] *= __uint_as_float(z.x << 16); a[1] *= __uint_as_float(z.x & 0xffff0000u); a[2] *= __uint_as_float(z.y << 16); a[3] *= __uint_as_float(z.y & 0xffff0000u);
                    b[0] *= __uint_as_float(z.z << 16); b[1] *= __uint_as_float(z.z & 0xffff0000u); b[2] *= __uint_as_float(z.w << 16); b[3] *= __uint_as_float(z.w & 0xffff0000u);
                    *(u32x4*)(YB + off) = pack8(a, b); } }
            asm volatile("" ::: "memory");
        }
    }
};
template <int L> __device__ __forceinline__ void phase_fnet_mix(const Params& p, unsigned char* lds) {
    constexpr int M = L == 3 ? ML : MT;
    pg8::Gemm g{8192, 512, 512};
    SchedLin S; S.init(M, 4096, gridDim.x, blockIdx.x, true); S.A0 = (const char*)(p.ws + WS_TO); S.B0 = (const char*)(p.ws + WS_BMIX); S.sAm = (size_t)256 * 8192 * 2; S.sAn = 512 * 2; S.sBm = 0; S.sBn = 256 * 512 * 2;
    EpiMix E{(const bf16*)(p.ws + WS_ZB), (bf16*)(p.ws + WS_YB_F)};
    pg8::gemm_phase<EpiMix, SchedLin>((PG8_LAS unsigned char*)lds, g, S, E);
}

struct SchedAttnIn : pg8::StaticOrder {
    const char* HBp; const char* WINp;
    __device__ __forceinline__ const char* aptr(const Unit& u) const { return ((u.pn == 18 || u.pn == 19) ? WINp + (size_t)u.pn * (256 * 2048 * 2) : HBp + (size_t)u.pm * (256 * 2048 * 2)) + (size_t)u.roff * (2048 * 2); }
    __device__ __forceinline__ const char* bptr(const Unit& u) const { return (u.pn == 18 || u.pn == 19) ? HBp + (size_t)u.pm * (256 * 2048 * 2) : WINp + (size_t)u.pn * (256 * 2048 * 2); }
};
__device__ __forceinline__ u32x2 pack4(const pg8::f32x4& a) { u32x2 w; w.x = pg8::cvt_pk_bf16(a[0], a[1]); w.y = pg8::cvt_pk_bf16(a[2], a[3]); return w; }
struct EpiAttnIn {
    static constexpr bool PERM = false;
    unsigned char* ws;
    __device__ __forceinline__ void operator()(const pg8::f32x4 (&acc)[2][2][4][2], const Unit& u, int wr, int wc, int fr, int fq) const {
        { int t_ = tidx(); fr = t_ & 15; fq = (t_ >> 4) & 3; }
        if (u.pn < 18) {
            const bool isq = u.pn < 16; bf16* const O = isq ? (bf16*)(ws + WS_QB) : (bf16*)(ws + WS_KB); const int ldo = isq ? 4096 : 512; const int cb = (isq ? u.pn : u.pn - 16) * 256 + wc * 32 + 4 * fq;
            const float sc = isq ? 0.125f * 1.4426950408889634f : 1.f; const float* rope = (const float*)(ws + TAB_ROPE);
#pragma unroll
            for (int ai = 0; ai < 2; ++ai)
#pragma unroll
                for (int m = 0; m < 4; ++m) { if (ai >= u.na) break; const int row = u.pm * 256 + u.roff + ai * 128 + wr * 64 + m * 16 + fr;
                    pg8::f32x4 c4 = (pg8::f32x4){1.f, 1.f, 1.f, 1.f}, s4 = (pg8::f32x4){0.f, 0.f, 0.f, 0.f};
                    if (row < ML) { const int t = row & 8191, pos = (wc & 1) ? (t & 63) : (t >> 6); const pg8::f32x4 r0 = *(const pg8::f32x4*)(rope + 2 * (pos * 16 + 4 * fq)), r1 = *(const pg8::f32x4*)(rope + 2 * (pos * 16 + 4 * fq) + 4);
                        c4 = (pg8::f32x4){r0[0], r0[2], r1[0], r1[2]}; s4 = (pg8::f32x4){r0[1], r0[3], r1[1], r1[3]}; }
#pragma unroll
                    for (int bj = 0; bj < 2; ++bj) { const pg8::f32x4 x1 = acc[ai][bj][m][0], x2 = acc[ai][bj][m][1];
                        const pg8::f32x4 y1 = (x1 * c4 - x2 * s4) * sc, y2 = (x1 * s4 + x2 * c4) * sc; bf16* o = O + (size_t)row * ldo + cb + bj * 128;
                        *(u32x2*)o = pack4(y1); *(u32x2*)(o + 16) = pack4(y2); }
                    if (m == 3) asm volatile("" ::: "memory"); }
        } else if (u.pn < 20) {
#pragma unroll
            for (int ai = 0; ai < 2; ++ai)
#pragma unroll
                for (int m = 0; m < 4; ++m) { if (ai >= u.na) break; const int ch = (u.pn - 18) * 256 + u.roff + ai * 128 + wr * 64 + m * 16 + fr;
#pragma unroll
                    for (int bj = 0; bj < 2; ++bj)
#pragma unroll
                        for (int n = 0; n < 2; ++n) { const int tcol = bj * 128 + wc * 32 + n * 16 + 4 * fq; bf16* dst;
                            if (u.pm < 64) { const int tk = u.pm * 256 + tcol; dst = (bf16*)(ws + WS_VT) + ((size_t)((tk >> 13) * 512 + ch) * 8192 + (tk & 8191)); }
                            else dst = (bf16*)(ws + WS_VTC) + ((size_t)((u.pm - 64) * 512 + ch) * 256 + tcol);
                            *(u32x2*)dst = pack4(acc[ai][bj][m][n]); } }
        } else {
            bf16* const ZB = (bf16*)(ws + WS_ZA);
#pragma unroll
            for (int ai = 0; ai < 2; ++ai)
#pragma unroll
                for (int m = 0; m < 4; ++m) { if (ai >= u.na) break; const int row = u.pm * 256 + u.roff + ai * 128 + wr * 64 + m * 16 + fr;
#pragma unroll
                    for (int bj = 0; bj < 2; ++bj)
#pragma unroll
                        for (int n = 0; n < 2; ++n) { pg8::f32x4 a = acc[ai][bj][m][n];
#pragma unroll
                            for (int e = 0; e < 4; ++e) a[e] = silu_f(a[e]);
                            *(u32x2*)(ZB + (size_t)row * 4096 + (u.pn - 20) * 256 + bj * 128 + wc * 32 + n * 16 + 4 * fq) = pack4(a); } }
        }
    }
};
__device__ __forceinline__ void phase_inproj_attn(const Params& p, unsigned char* lds) {
    pg8::Gemm g{DM, DM, DM};
    SchedAttnIn S; S.init(MT, 9216, gridDim.x, blockIdx.x, true); S.HBp = (const char*)(p.ws + WS_HB); S.WINp = (const char*)(p.ws + WS_WIN);
    EpiAttnIn E{p.ws};
    pg8::gemm_phase<EpiAttnIn, SchedAttnIn>((PG8_LAS unsigned char*)lds, g, S, E);
}
typedef short bf16x8_t __attribute__((ext_vector_type(8)));
typedef float f32x16 __attribute__((ext_vector_type(16)));
#define MFMA32(a, b, c) __builtin_amdgcn_mfma_f32_32x32x16_bf16((a), (b), (c), 0, 0, 0)
__device__ __forceinline__ bf16x8_t pack_step(const f32x16& x, int s) {
    u32x4 q;
    asm volatile("s_nop 3\n\tv_cvt_pk_bf16_f32 %0, %4, %5\n\tv_cvt_pk_bf16_f32 %1, %6, %7\n\tv_cvt_pk_bf16_f32 %2, %8, %9\n\tv_cvt_pk_bf16_f32 %3, %10, %11\n\ts_nop 1"
                 : "=&v"(q[0]), "=&v"(q[1]), "=&v"(q[2]), "=&v"(q[3])
                 : "v"(x[8 * s]), "v"(x[8 * s + 1]), "v"(x[8 * s + 2]), "v"(x[8 * s + 3]), "v"(x[8 * s + 4]), "v"(x[8 * s + 5]), "v"(x[8 * s + 6]), "v"(x[8 * s + 7]));
    return __builtin_bit_cast(bf16x8_t, q);
}
__device__ __forceinline__ void phase_attn(const Params& p, unsigned char* lds) {
    const int tid = tidx(), lane = tid & 63, wave = __builtin_amdgcn_readfirstlane(tid >> 6), r = lane & 31, h = lane >> 5;
    const bf16* QB = (const bf16*)(p.ws + WS_QB); const bf16* KB = (const bf16*)(p.ws + WS_KB); const bf16* VT = (const bf16*)(p.ws + WS_VT); const bf16* VTC = (const bf16*)(p.ws + WS_VTC);
    const bf16* ZB = (const bf16*)(p.ws + WS_ZA); bf16* YB = (bf16*)(p.ws + WS_YB); const float* sink = p.in[11];
    const int sk = tid >> 3, sp = tid & 7;
    constexpr int BUF = 18432, VOFF = 9216, RS = 144;
    for (int item = blockIdx.x; item < 2112; item += gridDim.x) {
        int b, kvh, q0, qrow0, cfirst, nw;
        if (item < 2048) { b = item >> 10; kvh = (item >> 7) & 7; q0 = (item & 127) * 64; qrow0 = b * 8192 + q0;
            cfirst = q0 < 128 ? (128 - q0) >> 6 : 0; const int clast = q0 > 8000 ? (8256 - q0) >> 6 : 4; nw = clast - cfirst + 1; }
        else { const int i2 = item - 2048; b = i2 >> 5; kvh = (i2 >> 2) & 7; q0 = (i2 & 3) * 64; qrow0 = ML + b * 256 + q0; cfirst = 0; nw = 0; }
        const int nch = nw + 4, hq = kvh * 8 + wave;
        bf16x8_t Qf[2][4];
#pragma unroll
        for (int sb = 0; sb < 2; ++sb)
#pragma unroll
            for (int st = 0; st < 4; ++st) Qf[sb][st] = *(const bf16x8_t*)((const char*)QB + (size_t)(unsigned)(((qrow0 + sb * 32 + r) * 4096 + hq * 64 + 16 * st + 8 * h) * 2));
        float mrun[2], lrun[2]; f32x16 O[2][2];
#pragma unroll
        for (int sb = 0; sb < 2; ++sb) { mrun[sb] = sink[hq] * 1.4426950408889634f; lrun[sb] = h == 0 ? 1.f : 0.f;
#pragma unroll
            for (int dt = 0; dt < 2; ++dt)
#pragma unroll
                for (int i = 0; i < 16; ++i) O[sb][dt][i] = 0.f; }
        u32x4 kreg, vreg;
#define ATT_SRC(j, kp_, vp_) do { if ((j) < nw) { const int kpos0_ = q0 - 128 + 64 * (cfirst + (j)); kp_ = (const char*)KB + (size_t)(unsigned)((((b * 8192 + kpos0_ + sk) * 512) + kvh * 64 + sp * 8) * 2); vp_ = (const char*)VT + (size_t)(unsigned)((((b * 512 + kvh * 64 + sk) * 8192) + kpos0_ + sp * 8) * 2); } \
        else { const int kc = 64 * ((j) - nw); kp_ = (const char*)KB + (size_t)(unsigned)((((ML + b * 256 + kc + sk) * 512) + kvh * 64 + sp * 8) * 2); vp_ = (const char*)VTC + (size_t)(unsigned)((((b * 512 + kvh * 64 + sk) * 256) + kc + sp * 8) * 2); } } while (0)
        { const char* kp; const char* vp; ATT_SRC(0, kp, vp); kreg = *(const u32x4*)kp; vreg = *(const u32x4*)vp;
          *(u32x4*)(lds + sk * RS + sp * 16) = kreg; *(u32x4*)(lds + VOFF + sk * RS + sp * 16) = vreg; }
        __syncthreads();
        for (int j = 0; j < nch; ++j) {
            const bool more = j + 1 < nch;
            if (more) { const char* kp; const char* vp; ATT_SRC(j + 1, kp, vp); kreg = *(const u32x4*)kp; vreg = *(const u32x4*)vp; }
            const unsigned char* Kb = lds + (j & 1) * BUF; const unsigned char* Vb = Kb + VOFF;
            const int cw = cfirst + j; const bool mlo = (j < nw) && cw == 0, mhi = (j < nw) && cw == 4; const int kpos0 = q0 - 128 + 64 * cw;
            f32x16 sc[2][2];
#pragma unroll
            for (int sb = 0; sb < 2; ++sb) {
#pragma unroll
                for (int i = 0; i < 16; ++i) { sc[sb][0][i] = 0.f; sc[sb][1][i] = 0.f; }
#pragma unroll
                for (int st = 0; st < 4; ++st) { const bf16x8_t k0 = *(const bf16x8_t*)(Kb + r * RS + (16 * st + 8 * h) * 2), k1 = *(const bf16x8_t*)(Kb + (32 + r) * RS + (16 * st + 8 * h) * 2);
                    sc[sb][0] = MFMA32(k0, Qf[sb][st], sc[sb][0]); sc[sb][1] = MFMA32(k1, Qf[sb][st], sc[sb][1]); }
            }
#pragma unroll
            for (int sb = 0; sb < 2; ++sb) {
                f32x16& s0 = sc[sb][0]; f32x16& s1 = sc[sb][1];
                if (mlo || mhi) { const int qpos = q0 + sb * 32 + r, lo_t = mlo ? qpos - 128 : -(1 << 30), hi_t = mhi ? qpos + 128 : (1 << 30);
#pragma unroll
                    for (int i = 0; i < 16; ++i) { const int kp0 = kpos0 + (i & 3) + 8 * (i >> 2) + 4 * h, kp1 = kp0 + 32;
                        s0[i] = (kp0 < lo_t || kp0 > hi_t) ? -1e30f : s0[i]; s1[i] = (kp1 < lo_t || kp1 > hi_t) ? -1e30f : s1[i]; } }
                float mx = fmaxf(s0[0], s1[0]);
#pragma unroll
                for (int i = 1; i < 16; ++i) mx = fmaxf(mx, fmaxf(s0[i], s1[i]));
                mx = fmaxf(mx, __shfl_xor(mx, 32));
                const float mn = fmaxf(mrun[sb], mx), al = __builtin_amdgcn_exp2f(mrun[sb] - mn); mrun[sb] = mn;
                float rs = 0.f;
#pragma unroll
                for (int i = 0; i < 16; ++i) { s0[i] = __builtin_amdgcn_exp2f(s0[i] - mn); s1[i] = __builtin_amdgcn_exp2f(s1[i] - mn); rs += s0[i] + s1[i]; }
                lrun[sb] = lrun[sb] * al + rs;
#pragma unroll
                for (int dt = 0; dt < 2; ++dt)
#pragma unroll
                    for (int i = 0; i < 16; ++i) O[sb][dt][i] *= al;
#pragma unroll
                for (int kt = 0; kt < 2; ++kt)
#pragma unroll
                    for (int st = 0; st < 2; ++st) { const bf16x8_t pf = pack_step(kt ? s1 : s0, st);
#pragma unroll
                        for (int dt = 0; dt < 2; ++dt) { const unsigned char* va = Vb + (32 * dt + r) * RS + (32 * kt + 16 * st + 4 * h) * 2;
                            const u32x2 v0 = *(const u32x2*)va, v1 = *(const u32x2*)(va + 16); u32x4 vv; vv.x = v0.x; vv.y = v0.y; vv.z = v1.x; vv.w = v1.y;
                            O[sb][dt] = MFMA32(__builtin_bit_cast(bf16x8_t, vv), pf, O[sb][dt]); } }
            }
            if (more) { unsigned char* nb = lds + ((j + 1) & 1) * BUF; *(u32x4*)(nb + sk * RS + sp * 16) = kreg; *(u32x4*)(nb + VOFF + sk * RS + sp * 16) = vreg; }
            __syncthreads();
        }
#undef ATT_SRC
        u32x2 zv[2][2][4];
#pragma unroll
        for (int sb = 0; sb < 2; ++sb) { const unsigned rowoff = (unsigned)((qrow0 + sb * 32 + r) * 4096 + hq * 64);
#pragma unroll
            for (int dt = 0; dt < 2; ++dt)
#pragma unroll
                for (int g4 = 0; g4 < 4; ++g4) zv[sb][dt][g4] = *(const u32x2*)(ZB + (size_t)(rowoff + 32 * dt + 8 * g4 + 4 * h)); }
#pragma unroll
        for (int sb = 0; sb < 2; ++sb) { const float lt = lrun[sb] + __shfl_xor(lrun[sb], 32), il = __builtin_amdgcn_rcpf(lt); const unsigned rowoff = (unsigned)((qrow0 + sb * 32 + r) * 4096 + hq * 64);
#pragma unroll
            for (int dt = 0; dt < 2; ++dt)
#pragma unroll
                for (int g4 = 0; g4 < 4; ++g4) { const size_t off = (size_t)(rowoff + 32 * dt + 8 * g4 + 4 * h); const u32x2 z = zv[sb][dt][g4];
                    const float y0 = O[sb][dt][4 * g4 + 0] * il * __uint_as_float(z.x << 16), y1 = O[sb][dt][4 * g4 + 1] * il * __uint_as_float(z.x & 0xffff0000u);
                    const float y2 = O[sb][dt][4 * g4 + 2] * il * __uint_as_float(z.y << 16), y3 = O[sb][dt][4 * g4 + 3] * il * __uint_as_float(z.y & 0xffff0000u);
                    u32x2 w; w.x = pg8::cvt_pk_bf16(y0, y1); w.y = pg8::cvt_pk_bf16(y2, y3); *(u32x2*)(YB + off) = w; } }
    }
}

__device__ __forceinline__ float gelu_fast(float x) { const float u = x * (1.5957691216057308f + 0.07135481627159768f * x * x); return x * __builtin_amdgcn_rcpf(1.f + __builtin_amdgcn_exp2f(-1.4426950408889634f * u)); }
struct EpiGmlpIn {
    static constexpr bool PERM = true;
    unsigned char* ws;
    __device__ __forceinline__ void operator()(const pg8::f32x4 (&acc)[2][2][4][2], const Unit& u, int wr, int wc, int fr, int fq) const {
        { int t_ = tidx(); fr = t_ & 15; fq = (t_ >> 4) & 3; }
        const int kind = u.pn >> 4; bf16* const O = (bf16*)(ws + (kind == 0 ? WS_UG : (kind == 1 ? WS_VG : WS_ZG))); const int cb = (u.pn & 15) * 256 + wc * 32 + 8 * fq;
#pragma unroll
        for (int ai = 0; ai < 2; ++ai)
#pragma unroll
            for (int m = 0; m < 4; ++m) { if (ai >= u.na) break; const int row = u.pm * 256 + u.roff + ai * 128 + wr * 64 + m * 16 + fr; float s1 = 0.f, s2 = 0.f;
#pragma unroll
                for (int bj = 0; bj < 2; ++bj) { pg8::f32x4 a = acc[ai][bj][m][0], b = acc[ai][bj][m][1];
                    if (kind == 2) {
#pragma unroll
                        for (int e = 0; e < 4; ++e) { a[e] = silu_f(a[e]); b[e] = silu_f(b[e]); } }
                    else {
#pragma unroll
                        for (int e = 0; e < 4; ++e) { a[e] = gelu_fast(a[e]); b[e] = gelu_fast(b[e]); s1 += a[e] + b[e]; s2 += a[e] * a[e] + b[e] * b[e]; } }
                    *(u32x4*)(O + (size_t)row * 4096 + cb + bj * 128) = pack8(a, b); }
                if (kind == 1) { s1 += __shfl_xor(s1, 16); s1 += __shfl_xor(s1, 32); s2 += __shfl_xor(s2, 16); s2 += __shfl_xor(s2, 32);
                    if (fq == 0) { float* st = (float*)(ws + WS_STAT) + ((size_t)row * 64 + (u.pn - 16) * 4 + wc) * 2; st[0] = s1; st[1] = s2; } } }
    }
};
__device__ __forceinline__ void phase_inproj_gmlp(const Params& p, unsigned char* lds) {
    pg8::Gemm g{DM, DM, DM};
    SchedLin S; S.init(MT, 12288, gridDim.x, blockIdx.x, true); S.plain(p.ws + WS_HB, DM, p.ws + WS_WIN, DM);
    EpiGmlpIn E{p.ws};
    pg8::gemm_phase<EpiGmlpIn, SchedLin>((PG8_LAS unsigned char*)lds, g, S, E);
}
template <int NTOK> __device__ __forceinline__ void gmlp_ln_item(const Params& p, unsigned char* lds, int chunk, int toff) {
    const int tid = tidx();
    float* mr = (float*)lds;
    bf16* T = (bf16*)(lds + 1024);
    const bf16* VG = (const bf16*)(p.ws + WS_VG); bf16* VT2 = (bf16*)(p.ws + WS_VT2); const float* STAT = (const float*)(p.ws + WS_STAT);
    const float* lg = p.in[15]; const float* lb = p.in[16];
    const int row0 = chunk * 128 + toff;
    __syncthreads();
    { const int t = tid >> 3, q = tid & 7;
      if (t < NTOK) { const float* st = STAT + ((size_t)(row0 + t) * 64 + q * 8) * 2; float s1 = 0.f, s2 = 0.f;
#pragma unroll
          for (int e = 0; e < 8; ++e) { s1 += st[2 * e]; s2 += st[2 * e + 1]; }
          s1 += __shfl_xor(s1, 1); s1 += __shfl_xor(s1, 2); s1 += __shfl_xor(s1, 4); s2 += __shfl_xor(s2, 1); s2 += __shfl_xor(s2, 2); s2 += __shfl_xor(s2, 4);
          if (q == 0) { const float mu = s1 * (1.f / 4096.f); const float var = fmaxf(s2 * (1.f / 4096.f) - mu * mu, 0.f); mr[2 * t] = mu; mr[2 * t + 1] = rsqrtf(var + EPS); } } }
    __syncthreads();
    u32x4 wv[NTOK / 16], wn[NTOK / 16];
#pragma unroll
    for (int i = 0; i < NTOK / 16; ++i) { const int pc = tid + i * NTHR, t = pc >> 5, c8 = (pc & 31) * 8; wv[i] = *(const u32x4*)(VG + (size_t)(row0 + t) * 4096 + c8); }
    for (int g = 0; g < 16; ++g) {
        if (g < 15) {
#pragma unroll
            for (int i = 0; i < NTOK / 16; ++i) { const int pc = tid + i * NTHR, t = pc >> 5, c8 = (pc & 31) * 8; wn[i] = *(const u32x4*)(VG + (size_t)(row0 + t) * 4096 + (g + 1) * 256 + c8); } }
#pragma unroll
        for (int i = 0; i < NTOK / 16; ++i) { const int pc = tid + i * NTHR, t = pc >> 5, c8 = (pc & 31) * 8; const u32x4 w = wv[i];
            const float mu = mr[2 * t], rs = mr[2 * t + 1]; const f32x4 g0 = *(const f32x4*)(lg + g * 256 + c8), g1 = *(const f32x4*)(lg + g * 256 + c8 + 4), b0 = *(const f32x4*)(lb + g * 256 + c8), b1 = *(const f32x4*)(lb + g * 256 + c8 + 4);
            u32x4 o; o.x = pk2((__uint_as_float(w.x << 16) - mu) * rs * g0.x + b0.x, (__uint_as_float(w.x & 0xffff0000u) - mu) * rs * g0.y + b0.y);
            o.y = pk2((__uint_as_float(w.y << 16) - mu) * rs * g0.z + b0.z, (__uint_as_float(w.y & 0xffff0000u) - mu) * rs * g0.w + b0.w);
            o.z = pk2((__uint_as_float(w.z << 16) - mu) * rs * g1.x + b1.x, (__uint_as_float(w.z & 0xffff0000u) - mu) * rs * g1.y + b1.y);
            o.w = pk2((__uint_as_float(w.w << 16) - mu) * rs * g1.z + b1.z, (__uint_as_float(w.w & 0xffff0000u) - mu) * rs * g1.w + b1.w);
            *(u32x4*)(T + t * 264 + c8) = o; }
        __syncthreads();
        { const int c = tid >> 1, t0 = (tid & 1) * (NTOK / 2); bf16* dst = VT2 + ((size_t)(chunk * 4096 + g * 256 + c) * 128 + toff + t0);
#pragma unroll
          for (int q = 0; q < NTOK / 16; ++q) { u32x4 o; const bf16* sp = T + (t0 + 8 * q) * 264 + c;
              o.x = (unsigned)sp[0] | ((unsigned)sp[264] << 16); o.y = (unsigned)sp[2 * 264] | ((unsigned)sp[3 * 264] << 16); o.z = (unsigned)sp[4 * 264] | ((unsigned)sp[5 * 264] << 16); o.w = (unsigned)sp[6 * 264] | ((unsigned)sp[7 * 264] << 16);
              *(u32x4*)(dst + 8 * q) = o; } }
        __syncthreads();
#pragma unroll
        for (int i = 0; i < NTOK / 16; ++i) wv[i] = wn[i];
    }
}
__device__ __forceinline__ void phase_gmlp_ln(const Params& p, unsigned char* lds) {
    for (int item = blockIdx.x; item < 256 + 32; item += gridDim.x) {
        if (item < 256) gmlp_ln_item<64>(p, lds, item >> 1, (item & 1) * 64);
        else { const int i2 = item - 256; gmlp_ln_item<16>(p, lds, 128 + (i2 >> 3), (i2 & 7) * 16); }
    }
}
struct EpiGmlpS {
    static constexpr bool PERM = true;
    unsigned char* ws; const float* bs;
    __device__ __forceinline__ void operator()(const pg8::f32x4 (&acc)[2][2][4][2], const Unit& u, int wr, int wc, int fr, int fq) const {
        { int t_ = tidx(); fr = t_ & 15; fq = (t_ >> 4) & 3; }
        bf16* const UG = (bf16*)(ws + WS_UG); const bf16* const ZG = (const bf16*)(ws + WS_ZG);
        u32x4 uv[4][2], zv[4][2]; float bias[4];
#pragma unroll
        for (int m = 0; m < 4; ++m) { const int sl = wr * 64 + m * 16 + fr; bias[m] = bs[u.pn * 128 + sl];
#pragma unroll
            for (int bj = 0; bj < 2; ++bj) { const size_t off = (size_t)(u.pm * 128 + sl) * 4096 + u.pn * 256 + bj * 128 + wc * 32 + 8 * fq; uv[m][bj] = *(const u32x4*)(UG + off); zv[m][bj] = *(const u32x4*)(ZG + off); } }
#pragma unroll
        for (int m = 0; m < 4; ++m) { const int sl = wr * 64 + m * 16 + fr;
#pragma unroll
            for (int bj = 0; bj < 2; ++bj) { const size_t off = (size_t)(u.pm * 128 + sl) * 4096 + u.pn * 256 + bj * 128 + wc * 32 + 8 * fq;
                const u32x4 uu = uv[m][bj], zz = zv[m][bj]; pg8::f32x4 a = acc[0][bj][m][0] + bias[m], b = acc[0][bj][m][1] + bias[m];
                a[0] *= __uint_as_float(uu.x << 16) * __uint_as_float(zz.x << 16); a[1] *= __uint_as_float(uu.x & 0xffff0000u) * __uint_as_float(zz.x & 0xffff0000u);
                a[2] *= __uint_as_float(uu.y << 16) * __uint_as_float(zz.y << 16); a[3] *= __uint_as_float(uu.y & 0xffff0000u) * __uint_as_float(zz.y & 0xffff0000u);
                b[0] *= __uint_as_float(uu.z << 16) * __uint_as_float(zz.z << 16); b[1] *= __uint_as_float(uu.z & 0xffff0000u) * __uint_as_float(zz.z & 0xffff0000u);
                b[2] *= __uint_as_float(uu.w << 16) * __uint_as_float(zz.w << 16); b[3] *= __uint_as_float(uu.w & 0xffff0000u) * __uint_as_float(zz.w & 0xffff0000u);
                *(u32x4*)(UG + off) = pack8(a, b); } }
    }
};
__device__ __forceinline__ void phase_gmlp_spatial(const Params& p, unsigned char* lds) {
    pg8::Gemm g{128, 128, 128};
    SchedLin S; S.init(132 * 256, 4096, gridDim.x, blockIdx.x); S.A0 = (const char*)(p.ws + WS_WSB); S.sAm = 0; S.sAn = 128 * 128 * 2; S.B0 = (const char*)(p.ws + WS_VT2); S.sBm = (size_t)4096 * 128 * 2; S.sBn = 256 * 128 * 2;
    EpiGmlpS E{p.ws, p.in[14]};
    pg8::gemm_phase<EpiGmlpS, SchedLin, true>((PG8_LAS unsigned char*)lds, g, S, E);
}

__device__ __forceinline__ void phase_final(const Params& p) {
    const int lane = tidx() & 63, gw = blockIdx.x * NWAVES + (tidx() >> 6), NGW = gridDim.x * NWAVES;
    const float* gvec = p.in[17];
    f32x4 x[8], xn[8];
    int row = gw;
    if (row < ML) {
#pragma unroll
        for (int j = 0; j < 8; ++j) x[j] = *(const f32x4*)(p.out + (size_t)row * DM + 4 * lane + 256 * j); }
    for (; row < ML; row += NGW) {
        const int rn = row + NGW;
        if (rn < ML) {
#pragma unroll
            for (int j = 0; j < 8; ++j) xn[j] = *(const f32x4*)(p.out + (size_t)rn * DM + 4 * lane + 256 * j); }
        float* xr = p.out + (size_t)row * DM; float s = 0.f;
#pragma unroll
        for (int j = 0; j < 8; ++j) s += (x[j].x * x[j].x + x[j].y * x[j].y) + (x[j].z * x[j].z + x[j].w * x[j].w);
        const float rstd = rsqrtf(wave_sum(s) * (1.f / DM) + EPS);
#pragma unroll
        for (int j = 0; j < 8; ++j) { const int c0 = 4 * lane + 256 * j; const f32x4 g4 = *(const f32x4*)(gvec + c0); *(f32x4*)(xr + c0) = x[j] * rstd * g4; }
#pragma unroll
        for (int j = 0; j < 8; ++j) x[j] = xn[j];
    }
}

#define XB_TMO      128
#define XB_XCNT(j)  (256  + 64 * (j))
#define XB_XSUB(j)  (1280 + 64 * (j))
#define XB_XGEN(j)  (2304 + 64 * (j))
#define XB_TOP      3328
#define XB_TOPGEN   3392
#define XCD_BAR_WORDS 3456
#define XB_SPIN_CAP (1u << 22)
__device__ __forceinline__ unsigned xb_ld(unsigned* p)              { return __hip_atomic_load(p, __ATOMIC_RELAXED, __HIP_MEMORY_SCOPE_AGENT); }
__device__ __forceinline__ unsigned xb_add(unsigned* p, unsigned v) { return __hip_atomic_fetch_add(p, v, __ATOMIC_RELAXED, __HIP_MEMORY_SCOPE_AGENT); }
__device__ __forceinline__ unsigned xb_xcc_id() { return (unsigned)__builtin_amdgcn_s_getreg((3 << 11) | 20) & 0xFu; }
#define XB_SPIN(cond, bar) do { unsigned _sp = 0; while (cond) { __builtin_amdgcn_s_sleep(1); \
    if ((++_sp & 255u) == 0u) { if (xb_ld(&(bar)[XB_TMO])) break; if (_sp > XB_SPIN_CAP) { atomicAdd(&(bar)[XB_TMO], 1u); break; } } } } while (0)
struct XcdBarrier { unsigned* bar; unsigned x; volatile __attribute__((address_space(3))) unsigned* st; };
__device__ __forceinline__ XcdBarrier xcd_barrier_post(unsigned* bar, volatile __attribute__((address_space(3))) unsigned* st) {
    XcdBarrier b; b.bar = bar; b.x = xb_xcc_id(); b.st = st;
    if (threadIdx.x == 0) (void)xb_add(&bar[XB_XCNT(b.x)], 1u);
    return b;
}
__device__ __forceinline__ void xcd_barrier_complete(unsigned* bar, unsigned x, unsigned& nloc, unsigned& nx) {
    const unsigned G = gridDim.x * gridDim.y * gridDim.z;
    unsigned sum, cnt, mine, sp = 0u;
    for (;;) {
        sum = 0u; cnt = 0u; mine = 0u;
#pragma unroll
        for (unsigned j = 0; j < 16; ++j) { const unsigned c = xb_ld(&bar[XB_XCNT(j)]); sum += c; cnt += (c > 0u) ? 1u : 0u; mine = (j == x) ? c : mine; }
        if (sum == G) break;
        __builtin_amdgcn_s_sleep(1);
        if ((++sp & 255u) == 0u) { if (xb_ld(&bar[XB_TMO])) break; if (sp > XB_SPIN_CAP) { atomicAdd(&bar[XB_TMO], 1u); break; } }
    }
    nloc = mine > 0u ? mine : 1u; nx = cnt > 0u ? cnt : 1u;
}
__device__ __forceinline__ void xcd_barrier(const XcdBarrier& b) {
    asm volatile("s_waitcnt vmcnt(0)" ::: "memory");
    __syncthreads();
    if (threadIdx.x == 0) {
        unsigned* bar = b.bar;
        __builtin_amdgcn_s_waitcnt(0);
        unsigned nloc = b.st[0], nx = b.st[1];
        if (nloc == 0u) { xcd_barrier_complete(bar, b.x, nloc, nx); b.st[0] = nloc; b.st[1] = nx; }
        const unsigned old = xb_add(&bar[XB_XSUB(b.x)], 1u);
        const unsigned gen = old / nloc;
        if (old + 1u == (gen + 1u) * nloc) {
            __builtin_amdgcn_fence(__ATOMIC_RELEASE, "agent");
            asm volatile("s_waitcnt vmcnt(0)" ::: "memory");
            const unsigned og = xb_add(&bar[XB_TOP], 1u);
            const unsigned tg = og / nx;
            if (og + 1u == (tg + 1u) * nx) xb_add(&bar[XB_TOPGEN], 1u);
            else XB_SPIN(xb_ld(&bar[XB_TOPGEN]) == tg, bar);
            __builtin_amdgcn_fence(__ATOMIC_ACQUIRE, "agent");
            xb_add(&bar[XB_XGEN(b.x)], 1u);
            asm volatile("s_waitcnt vmcnt(0)" ::: "memory");
        } else {
            XB_SPIN(xb_ld(&bar[XB_XGEN(b.x)]) == gen, bar);
            __builtin_amdgcn_fence(__ATOMIC_ACQUIRE, "agent");
            asm volatile("s_waitcnt vmcnt(0)" ::: "memory");
        }
    }
    __syncthreads();
}

constexpr int NPH = 23;
__global__ void __launch_bounds__(NTHR, 2) fwd(Params p) {
    extern __shared__ __attribute__((aligned(16))) unsigned char lds[];
    cg::grid_group grid = cg::this_grid();
    const int lo = p.ph_lo, hi = p.ph_hi;
    volatile __attribute__((address_space(3))) unsigned* bst = (volatile __attribute__((address_space(3))) unsigned*)((__attribute__((address_space(3))) unsigned char*)lds + 131072 + 2048);
    if (threadIdx.x < 2) bst[threadIdx.x] = 0u;
    __syncthreads();
    const XcdBarrier xbar = xcd_barrier_post((unsigned*)(p.ws + WS_BAR), bst);
    if (hi > 1000) grid.sync();
#define PHASE(k, ...) if (lo <= (k) && (k) < hi) { __VA_ARGS__; if ((k) + 1 < hi) xcd_barrier(xbar); }
    PHASE(0, phase0(p, lds))
    PHASE(1, phase_prep<0>(p, lds))
    PHASE(2, phase_inproj_fnet<0>(p, lds))
    PHASE(3, phase_fnet_a(p, true, lds))
    PHASE(4, phase_fnet_c(p, lds))
    PHASE(5, phase_fnet_mix<0>(p, lds))
    PHASE(6, phase_outproj<0>(p, lds))
    PHASE(7, phase_prep<1>(p, lds))
    PHASE(8, phase_inproj_attn(p, lds))
    PHASE(9, phase_attn(p, lds))
    PHASE(10, phase_outproj<1>(p, lds))
    PHASE(11, phase_prep<2>(p, lds))
    PHASE(12, phase_inproj_gmlp(p, lds))
    PHASE(13, phase_gmlp_ln(p, lds))
    PHASE(14, phase_gmlp_spatial(p, lds))
    PHASE(15, phase_outproj<2>(p, lds))
    PHASE(16, phase_prep<3>(p, lds))
    PHASE(17, phase_inproj_fnet<3>(p, lds))
    PHASE(18, phase_fnet_a(p, false, lds))
    PHASE(19, phase_fnet_c(p, lds))
    PHASE(20, phase_fnet_mix<3>(p, lds))
    PHASE(21, phase_outproj<3>(p, lds))
    PHASE(22, phase_final(p))
#undef PHASE
}

extern "C" void kernel_launch(void* const* d_in, const int* in_sizes, int n_in, void* d_out, int out_size, void* d_ws, size_t ws_size, hipStream_t stream) {
    static int grid = 0;
    if (grid == 0) {
        int dev = 0, cus = 0, per_cu = 0;
        (void)hipGetDevice(&dev); (void)hipDeviceGetAttribute(&cus, hipDeviceAttributeMultiprocessorCount, dev);
        (void)hipFuncSetAttribute((const void*)fwd, hipFuncAttributeMaxDynamicSharedMemorySize, LDS_BYTES);
        (void)hipOccupancyMaxActiveBlocksPerMultiprocessor(&per_cu, (const void*)fwd, NTHR, LDS_BYTES);
        if (per_cu < 1) { fprintf(stderr, "kernel_launch: occupancy query says %d blocks per CU\n", per_cu); per_cu = 1; }
        (void)hipGetLastError();
        grid = cus;
        if (n_in != 18 || ws_size < WS_END) fprintf(stderr, "kernel_launch: unexpected n_in %d / ws_size %zu\n", n_in, ws_size);
    }
    (void)hipMemsetAsync((char*)d_ws + WS_BAR, 0, XCD_BAR_WORDS * 4, stream);
    Params p{};
    for (int i = 0; i < 18; ++i) p.in[i] = (const float*)d_in[i];
    p.out = (float*)d_out; p.ws = (unsigned char*)d_ws;
#if MK_COOP
    p.ph_lo = 0; p.ph_hi = NPH;
    void* args[] = {&p};
    hipError_t e = hipLaunchCooperativeKernel((const void*)fwd, dim3(grid), dim3(NTHR), args, LDS_BYTES, stream);
    if (e != hipSuccess) fprintf(stderr, "cooperative launch failed: %s (grid %d)\n", hipGetErrorString(e), grid);
#else
    for (int ph = 0; ph < NPH; ++ph) { p.ph_lo = ph; p.ph_hi = ph + 1; hipLaunchKernelGGL(fwd, dim3(grid), dim3(NTHR), LDS_BYTES, stream, p); }
#endif
}
```

```cpp
#include <hip/hip_runtime.h>
#include <hip/hip_cooperative_groups.h>
#include <cstdio>
#include <cstdint>
namespace cg = cooperative_groups;

#ifndef MK_COOP
#define MK_COOP 1
#endif

__device__ __forceinline__ int tidx() { int t = threadIdx.x; asm volatile("" : "+v"(t)); return t; }
namespace pg8 {
#define PG8_LAS __attribute__((address_space(3)))
typedef unsigned short bf16_t;
typedef short bf16x8 __attribute__((ext_vector_type(8)));
typedef float f32x4 __attribute__((ext_vector_type(4)));
typedef unsigned u32x4 __attribute__((ext_vector_type(4)));
constexpr int BM = 256, BK = 64, HALF = 128, HTB = HALF * BK * 2, STAGE_BYTES = 8 * HTB, NXCD = 8, WGM = 8;

__host__ __device__ __forceinline__ int lds_byte(int r, int c) { const int st = (r >> 4) * 2 + (c >> 5), rr = r & 15, cc = c & 31, ob = rr * 64 + cc * 2; return st * 1024 + (ob ^ (((ob >> 9) & 1) << 5)); }
__host__ __device__ __forceinline__ void stage_rc(int b, int& R, int& C) { const int st = b / 1024, sb = b % 1024, swz = sb ^ (((sb >> 9) & 1) << 5); R = (st >> 1) * 16 + swz / 64; C = (st & 1) * 32 + (swz % 64) / 2; }
__host__ __device__ __forceinline__ int perm32(int rho) { const int n = rho >> 4, i = rho & 15; return 8 * (i >> 2) + 4 * n + (i & 3); }

struct Unit { int pm, pn, na, roff; };
struct Gemm { int lda, ldb, K; };

struct StaticOrder {
    int nM, nN, nwg, G, c, nfull;
    __host__ __device__ void init(int M, int N, int G_, int c_, bool split = false) { nM = M / BM; nN = N / BM; nwg = nM * nN; G = G_; c = c_; nfull = nwg;
        if (split) { const int nf = (nwg / G) * G; if (2 * (nwg - nf) <= G) nfull = nf; } }
    __host__ __device__ void map(int wgid, Unit& u) const {
        { const int q = nwg / NXCD, r = nwg % NXCD, xcd = wgid % NXCD, off = wgid / NXCD; wgid = (xcd < r ? xcd * (q + 1) : r * (q + 1) + (xcd - r) * q) + off; }
        const int nig = WGM * nN, gid = wgid / nig, fm = gid * WGM, gsz = (nM - fm) < WGM ? (nM - fm) : WGM;
        u.pm = fm + ((wgid % nig) % gsz); u.pn = (wgid % nig) / gsz; }
    __host__ __device__ bool next(int i, Unit& u) const {
        const long L = (long)i * G + c;
        if (L < nfull) { map((int)L, u); u.na = 2; u.roff = 0; return true; }
        const long h = L - nfull; if (h >= 2L * (nwg - nfull)) return false;
        map(nfull + (int)(h >> 1), u); u.na = 1; u.roff = (int)(h & 1) * HALF; return true;
    }
};

__device__ __forceinline__ unsigned cvt_pk_bf16(float lo, float hi) { unsigned r; asm volatile("v_cvt_pk_bf16_f32 %0, %1, %2" : "=v"(r) : "v"(lo), "v"(hi)); return r; }

struct EpiResid {
    static constexpr bool PERM = false;
    const float* rl; float* xl; const float* gate;
    __device__ __forceinline__ void operator()(const f32x4 (&acc)[2][2][4][2], const Unit& u, int wr, int wc, int fr, int fq) const {
        { int t_ = tidx(); fr = t_ & 15; fq = (t_ >> 4) & 3; }
        const int col0 = u.pn * BM + wc * 32 + 4 * fq; const float* gp = gate + ((u.pm * BM) >> 13) * 6144 + 4096 + col0;
        f32x4 g4[2][2];
#pragma unroll
        for (int bj = 0; bj < 2; ++bj)
#pragma unroll
            for (int n = 0; n < 2; ++n) g4[bj][n] = *(const f32x4*)(gp + bj * HALF + n * 16);
#pragma unroll
        for (int ai = 0; ai < 2; ++ai) {
            f32x4 xv[4][2][2];
#pragma unroll
            for (int m = 0; m < 4; ++m) { const float* rr = rl + (size_t)(u.pm * BM + ai * HALF + wr * 64 + m * 16 + fr) * 2048 + col0;
#pragma unroll
                for (int bj = 0; bj < 2; ++bj)
#pragma unroll
                    for (int n = 0; n < 2; ++n) xv[m][bj][n] = *(const f32x4*)(rr + bj * HALF + n * 16); }
#pragma unroll
            for (int m = 0; m < 4; ++m) { float* xr = xl + (size_t)(u.pm * BM + ai * HALF + wr * 64 + m * 16 + fr) * 2048 + col0;
#pragma unroll
                for (int bj = 0; bj < 2; ++bj)
#pragma unroll
                    for (int n = 0; n < 2; ++n) *(f32x4*)(xr + bj * HALF + n * 16) = xv[m][bj][n] + g4[bj][n] * acc[ai][bj][m][n]; }
            asm volatile("" ::: "memory");
        }
    }
};

__device__ __forceinline__ const char* uni(const char* p) { const unsigned long long v = (unsigned long long)p; const unsigned lo = __builtin_amdgcn_readfirstlane((unsigned)v), hi = __builtin_amdgcn_readfirstlane((unsigned)(v >> 32)); return (const char*)(((unsigned long long)hi << 32) | lo); }
struct EpiPart {
    static constexpr bool PERM = false;
    float* part;
    __device__ __forceinline__ void operator()(const f32x4 (&acc)[2][2][4][2], const Unit& u, int wr, int wc, int fr, int fq) const {
        { int t_ = tidx(); fr = t_ & 15; fq = (t_ >> 4) & 3; }
        const int ks = u.pn >> 3, col0 = (u.pn & 7) * BM + wc * 32 + 4 * fq;
#pragma unroll
        for (int ai = 0; ai < 2; ++ai)
#pragma unroll
            for (int m = 0; m < 4; ++m) { float* o = part + ((size_t)(ks * 512 + u.pm * BM + ai * HALF + wr * 64 + m * 16 + fr)) * 2048 + col0;
#pragma unroll
                for (int bj = 0; bj < 2; ++bj)
#pragma unroll
                    for (int n = 0; n < 2; ++n) *(f32x4*)(o + bj * HALF + n * 16) = acc[ai][bj][m][n]; }
    }
};
template <class Epi, class Sched, bool HALFM = false>
__device__ __forceinline__ void gemm_phase(PG8_LAS unsigned char* lds, const Gemm g, const Sched& S, const Epi& E) {
    int tid_ = tidx();
    const int tid = tid_, wid = __builtin_amdgcn_readfirstlane(tid >> 6), lane = tid & 63, wr = wid >> 2, wc = wid & 3, fr = lane & 15, fq = lane >> 4;
    int K_ = g.K; asm volatile("" : "+s"(K_));
    const int K = K_, nt = K / BK;
    unsigned voffA[2], voffB[2];
#pragma unroll
    for (int i = 0; i < 2; ++i) { int R, C; stage_rc(tid * 16 + i * 8192, R, C); const int Rb = Epi::PERM ? ((R & ~31) + perm32(R & 31)) : R;
        voffA[i] = (unsigned)(R * g.lda + C) * 2u; voffB[i] = (unsigned)(Rb * g.ldb + C) * 2u; }
    const size_t kstep = (size_t)(BK * 2);
    const size_t hstepA = (size_t)HALF * g.lda * 2, hstepB = (size_t)HALF * g.ldb * 2;
    const unsigned ldsw = (unsigned)wid * 1024u;
    const int aoff = lds_byte(wr * 64 + fr, fq * 8), boff = lds_byte(wc * 32 + fr, fq * 8);
#define PG8_SA(b, h) (((b) * 2 + (h)) * HTB)
#define PG8_SB(b, h) ((4 + (b) * 2 + (h)) * HTB)
#define PG8_STAGE(bufoff, gbase, voff) do { _Pragma("unroll") for (int _i = 0; _i < 2; ++_i) \
        __builtin_amdgcn_global_load_lds((const unsigned*)((const char*)(gbase) + (voff)[_i]), (PG8_LAS unsigned*)(lds + (bufoff) + ldsw + _i * 8192), 16, 0, 0); } while (0)
#define PG8_LDA(dst, b, h) do { _Pragma("unroll") for (int m = 0; m < 4; ++m) _Pragma("unroll") for (int k = 0; k < 2; ++k) dst[m][k] = *(const PG8_LAS bf16x8*)(lds + PG8_SA(b, h) + aoff + m * 2048 + k * 1024); } while (0)
#define PG8_LDB(dst, b, h) do { _Pragma("unroll") for (int n = 0; n < 2; ++n) _Pragma("unroll") for (int k = 0; k < 2; ++k) dst[n][k] = *(const PG8_LAS bf16x8*)(lds + PG8_SB(b, h) + boff + n * 2048 + k * 1024); } while (0)
#define PG8_MMA(ai, bj, At, Bt) do { __builtin_amdgcn_s_setprio(1); _Pragma("unroll") for (int m = 0; m < 4; ++m) _Pragma("unroll") for (int n = 0; n < 2; ++n) _Pragma("unroll") for (int k = 0; k < 2; ++k) \
        acc[ai][bj][m][n] = __builtin_amdgcn_mfma_f32_16x16x32_bf16(Bt[n][k], At[m][k], acc[ai][bj][m][n], 0, 0, 0); __builtin_amdgcn_s_setprio(0); } while (0)
#define PG8_WAIT_V(n) asm volatile("s_waitcnt vmcnt(" #n ")" ::: "memory")
#define PG8_WAIT_L(n) asm volatile("s_waitcnt lgkmcnt(" #n ")" ::: "memory")
#define PG8_BAR __builtin_amdgcn_s_barrier()
#define PG8_SCHED __builtin_amdgcn_sched_barrier(0)
    Unit cur, nxt; int ui = 0;
    if (!S.next(0, cur)) return;
    f32x4 acc[2][2][4][2];
#pragma unroll
    for (int a = 0; a < 2; ++a)
#pragma unroll
        for (int b = 0; b < 2; ++b)
#pragma unroll
            for (int m = 0; m < 4; ++m)
#pragma unroll
                for (int n = 0; n < 2; ++n) acc[a][b][m][n] = (f32x4){0.f, 0.f, 0.f, 0.f};
    bf16x8 At[4][2], B0[2][2], B1[2][2];
    const char* cA = uni(S.aptr(cur)); const char* cB = uni(S.bptr(cur));
    {
        PG8_STAGE(PG8_SB(0, 0), cB, voffB); PG8_STAGE(PG8_SB(0, 1), cB + hstepB, voffB); PG8_STAGE(PG8_SA(0, 0), cA, voffA); PG8_STAGE(PG8_SA(0, 1), cA + hstepA, voffA);
        if (wr == 1) PG8_BAR;
        PG8_WAIT_V(2); PG8_BAR;
        PG8_STAGE(PG8_SB(1, 0), cB + kstep, voffB); PG8_STAGE(PG8_SA(1, 0), cA + kstep, voffA); PG8_STAGE(PG8_SB(1, 1), cB + hstepB + kstep, voffB);
        PG8_WAIT_V(6); PG8_BAR;
    }
    for (;;) {
        const bool has_next = S.next(ui + 1, nxt);
        const char* nA = has_next ? uni(S.aptr(nxt)) : cA; const char* nB = has_next ? uni(S.bptr(nxt)) : cB;
        for (int t = 0; t < nt; t += 2) {
            const bool last = (t == nt - 2);
            const char* a1 = cA + (size_t)(t + 1) * kstep;
            const char* a2 = last ? nA : cA + (size_t)(t + 2) * kstep; const char* b2 = last ? nB : cB + (size_t)(t + 2) * kstep;
            const char* a3 = a2 + kstep; const char* b3 = b2 + kstep;
            PG8_LDB(B0, 0, 0); PG8_LDB(B1, 0, 1); PG8_SCHED; PG8_LDA(At, 0, 0); PG8_STAGE(PG8_SA(1, 1), a1 + hstepA, voffA);
            PG8_WAIT_V(8); PG8_WAIT_L(0); PG8_BAR; PG8_MMA(0, 0, At, B0); PG8_MMA(0, 1, At, B1); PG8_BAR; PG8_SCHED;
            PG8_LDA(At, 0, 1); PG8_STAGE(PG8_SB(0, 0), b2, voffB); PG8_STAGE(PG8_SB(0, 1), b2 + hstepB, voffB); PG8_STAGE(PG8_SA(0, 0), a2, voffA);
            PG8_WAIT_V(8); PG8_WAIT_L(0); PG8_BAR; if (HALFM ? false : cur.na == 2) { PG8_MMA(1, 0, At, B0); PG8_MMA(1, 1, At, B1); } PG8_BAR; PG8_SCHED;
            PG8_LDB(B0, 1, 0); PG8_LDB(B1, 1, 1); PG8_SCHED; PG8_LDA(At, 1, 0); PG8_STAGE(PG8_SA(0, 1), a2 + hstepA, voffA);
            PG8_WAIT_V(8); PG8_WAIT_L(0); PG8_BAR; PG8_MMA(0, 0, At, B0); PG8_MMA(0, 1, At, B1); PG8_BAR; PG8_SCHED;
            PG8_LDA(At, 1, 1); PG8_STAGE(PG8_SB(1, 0), b3, voffB); PG8_STAGE(PG8_SB(1, 1), b3 + hstepB, voffB); PG8_STAGE(PG8_SA(1, 0), a3, voffA);
            PG8_WAIT_V(8); PG8_WAIT_L(0); PG8_BAR; if (HALFM ? false : cur.na == 2) { PG8_MMA(1, 0, At, B0); PG8_MMA(1, 1, At, B1); } PG8_BAR; PG8_SCHED;
        }
        if (wr == 0) PG8_BAR;
        E(acc, cur, wr, wc, fr, fq);
        if (!has_next) break;
#pragma unroll
        for (int a = 0; a < 2; ++a)
#pragma unroll
            for (int b = 0; b < 2; ++b)
#pragma unroll
                for (int m = 0; m < 4; ++m)
#pragma unroll
                    for (int n = 0; n < 2; ++n) acc[a][b][m][n] = (f32x4){0.f, 0.f, 0.f, 0.f};
        cur = nxt; cA = nA; cB = nB; ++ui;
        if (wr == 1) PG8_BAR;
    }
    PG8_WAIT_V(0);
    PG8_BAR;
#undef PG8_SA
#undef PG8_SB
#undef PG8_STAGE
#undef PG8_LDA
#undef PG8_LDB
#undef PG8_MMA
#undef PG8_WAIT_V
#undef PG8_WAIT_L
#undef PG8_BAR
#undef PG8_SCHED
}
}

typedef unsigned short bf16;
typedef float f32x4 __attribute__((ext_vector_type(4)));
typedef unsigned u32x4 __attribute__((ext_vector_type(4)));
typedef unsigned u32x2 __attribute__((ext_vector_type(2)));
constexpr int DM = 2048, SEQ = 8192, ML = 16384, MC = 512, MT = ML + MC, DBR = 4096, CTXL = 256, DEPTH = 4;
constexpr int NTHR = 512, NWAVES = 8;
constexpr float EPS = 1e-6f;
constexpr size_t MiB = 1u << 20;
constexpr size_t WS_MOD = 0;
constexpr size_t WS_BAR = 512 * 1024;
constexpr size_t WS_XC = 1 * MiB;
constexpr size_t WS_TAB = 5 * MiB;
constexpr size_t TAB_ROPE = WS_TAB + 65536, TAB_DA = WS_TAB + 131072, TAB_CASPM = WS_TAB + 262144;
constexpr size_t WS_WIN = 8 * MiB;
constexpr size_t WS_WOUT = 56 * MiB;
constexpr size_t WS_BMIX = 72 * MiB;
constexpr size_t WS_HB = 76 * MiB;
constexpr size_t WS_PB = 142 * MiB;
constexpr size_t WS_YB = 538 * MiB;
constexpr size_t WS_QB = 142 * MiB;
constexpr size_t WS_KB = 274 * MiB;
constexpr size_t WS_VT = 291 * MiB;
constexpr size_t WS_VTC = 307 * MiB;
constexpr size_t WS_ZA = 308 * MiB;
constexpr size_t WS_UG = 142 * MiB;
constexpr size_t WS_VG = 274 * MiB;
constexpr size_t WS_ZG = 406 * MiB;
constexpr size_t WS_VT2 = 538 * MiB;
constexpr size_t WS_STAT = 670 * MiB;
constexpr size_t WS_WSB = 72 * MiB;
constexpr size_t WS_TO = 76 * MiB;
constexpr size_t WS_U1 = 142 * MiB;
constexpr size_t WS_UCT = 270 * MiB;
constexpr size_t WS_ZB = 340 * MiB;
constexpr size_t WS_YP = 472 * MiB;
constexpr size_t WS_YB_F = 472 * MiB;
constexpr size_t TAB_DC2 = 760 * MiB;
constexpr size_t WS_PART = 728 * MiB;
constexpr size_t WS_END = 768 * MiB;
static_assert(WS_YP + (size_t)256 * MiB <= WS_END && WS_YB + (size_t)MT * DBR * 2 <= WS_END, "ws map");
constexpr int LDS_BYTES = 135168;

struct Params { const float* in[18]; float* out; unsigned char* ws; int ph_lo, ph_hi; };

__device__ __forceinline__ float bf2f(bf16 h) { return __uint_as_float((unsigned)h << 16); }
__device__ __forceinline__ unsigned f2bf(float f) { unsigned u = __float_as_uint(f); return (u + 0x7fffu + ((u >> 16) & 1u)) >> 16; }
__device__ __forceinline__ unsigned pk2(float lo, float hi) { return f2bf(lo) | (f2bf(hi) << 16); }
__device__ __forceinline__ float silu_f(float x) { return x * __builtin_amdgcn_rcpf(1.f + __builtin_amdgcn_exp2f(-1.4426950408889634f * x)); }
__device__ __forceinline__ float wave_sum(float v) {
#pragma unroll
    for (int o = 1; o < 64; o <<= 1) v += __shfl_xor(v, o);
    return v;
}
#define LDS_WAIT() asm volatile("s_waitcnt lgkmcnt(0)" ::: "memory")

struct SchedLin : pg8::StaticOrder {
    const char* A0; const char* B0; size_t sAm, sAn, sBm, sBn;
    __device__ __forceinline__ const char* aptr(const pg8::Unit& u) const { return A0 + u.pm * sAm + u.pn * sAn + (size_t)u.roff * (sAm >> 8); }
    __device__ __forceinline__ const char* bptr(const pg8::Unit& u) const { return B0 + u.pm * sBm + u.pn * sBn; }
    __device__ __forceinline__ void plain(const void* A, int lda, const void* B, int ldb) { A0 = (const char*)A; B0 = (const char*)B; sAm = (size_t)256 * lda * 2; sAn = 0; sBm = 0; sBn = (size_t)256 * ldb * 2; }
};

__device__ __forceinline__ void phase0(const Params& p, unsigned char* lds) {
    const int tid = tidx(), lane = tid & 63, wave = tid >> 6, G = gridDim.x, bid = blockIdx.x;
    float* sv = (float*)lds;
    float* red = sv + 3 * 2048;
    const float* c = p.in[1]; const float* cctx = p.in[3];
    for (int i = tid; i < 3 * 2048; i += NTHR) { const float v = i < 4096 ? c[i] : cctx[i - 4096]; sv[i] = silu_f(v); }
    __syncthreads();
    float* mod = (float*)(p.ws + WS_MOD);
    const float* ada_w = p.in[5]; const float* ada_b = p.in[6];
    typedef float f32x2 __attribute__((ext_vector_type(2)));
    for (int it = bid; it < 4 * 48; it += G) {
        const int L = it / 48, jg = it % 48;
        const float* w = ada_w + (size_t)L * 2048 * 6144 + jg * 128 + 2 * lane;
        f32x2 a0 = {0.f, 0.f}, a1 = {0.f, 0.f}, a2 = {0.f, 0.f};
#pragma unroll 16
        for (int k = wave * 256; k < wave * 256 + 256; ++k) { const f32x2 wv = __builtin_nontemporal_load((const f32x2*)(w + (size_t)k * 6144)); a0 += sv[k] * wv; a1 += sv[2048 + k] * wv; a2 += sv[4096 + k] * wv; }
        f32x2* red2 = (f32x2*)red;
        red2[(wave * 3 + 0) * 64 + lane] = a0; red2[(wave * 3 + 1) * 64 + lane] = a1; red2[(wave * 3 + 2) * 64 + lane] = a2;
        __syncthreads();
        if (tid < 192) { const int v = tid >> 6, l = tid & 63; f32x2 s = {0.f, 0.f};
#pragma unroll
            for (int w8 = 0; w8 < 8; ++w8) s += red2[(w8 * 3 + v) * 64 + l];
            const f32x2 bb = *(const f32x2*)(ada_b + L * 6144 + jg * 128 + 2 * l);
            *(f32x2*)(mod + (size_t)(L * 3 + v) * 6144 + jg * 128 + 2 * l) = s + bb; }
        __syncthreads();
    }
    const int gt = bid * NTHR + tid, NT = G * NTHR;
    float* rope = (float*)(p.ws + TAB_ROPE);
    for (int j = gt; j < 128 * 16; j += NT) { const int pos = j >> 4, i = j & 15;
        const float inv = exp2f(-(float)i * (13.287712379549449f / 16.f)); const float ang = (float)pos * inv;
        double td = (double)ang * 0.15915494309189535; td -= floor(td); const float tf = (float)td;
        rope[2 * j] = __builtin_amdgcn_cosf(tf); rope[2 * j + 1] = __builtin_amdgcn_sinf(tf); }
    bf16* DA = (bf16*)(p.ws + TAB_DA); bf16* CPM = (bf16*)(p.ws + TAB_CASPM);
    for (int j = gt; j < 256 * 128; j += NT) { const int r = j >> 7, cc = j & 127;
        { const int k1 = r & 127; const float t = (float)((k1 * cc) & 127) * (1.f / 128.f); DA[j] = (bf16)f2bf(r < 128 ? __builtin_amdgcn_cosf(t) : -__builtin_amdgcn_sinf(t)); } }
    { bf16* DC2 = (bf16*)(p.ws + TAB_DC2);
      for (int j = gt; j < 129 * 128 * 128; j += NT) { const int cc = j & 127, r = (j >> 7) & 127, k1 = (j >> 14) & 127, ty = r >> 6, k2 = r & 63, n2 = cc >> 1, ri = cc & 1;
          const float t = (float)(((128 * k2 + k1) * n2) & 8191) * (1.f / 8192.f); const float c_ = __builtin_amdgcn_cosf(t), s_ = __builtin_amdgcn_sinf(t);
          DC2[j] = (bf16)f2bf(ty == 1 ? (ri == 0 ? c_ + s_ : s_ - c_) : (ri == 0 ? c_ - s_ : s_ + c_)); } }
    for (int j = gt; j < 512 * 256; j += NT) { const int r = j >> 8, n = j & 255, k = r & 255; const float t = (float)((k * n) & 255) * (1.f / 256.f); const float c_ = __builtin_amdgcn_cosf(t), s_ = __builtin_amdgcn_sinf(t);
        CPM[j] = (bf16)f2bf(r < 256 ? c_ - s_ : c_ + s_); }
}

__device__ __forceinline__ void transpose_all(const float* W, int ldw, int K, int ncols, bf16* WT, unsigned char* lds, int vb = -1, int nvb = 0) {
    const int tid = tidx(); float* tile = (float*)lds;
    const int nblk = ncols / 256, nitems = (K / 64) * nblk;
    if (vb < 0) { vb = blockIdx.x; nvb = gridDim.x; }
    f32x4 v[8];
    int it = vb;
    if (it < nitems) { const int k0 = 64 * (it / nblk), n0 = 256 * (it % nblk);
#pragma unroll
        for (int i = 0; i < 8; ++i) { const int pc = tid + i * NTHR, kk = pc >> 6, c4 = (pc & 63) * 4; v[i] = __builtin_nontemporal_load((const f32x4*)(W + (size_t)(k0 + kk) * ldw + n0 + c4)); } }
    for (; it < nitems; it += nvb) {
        const int kb = it / nblk, nb = it % nblk, k0 = 64 * kb, n0 = 256 * nb;
        __syncthreads();
#pragma unroll
        for (int i = 0; i < 8; ++i) { const int pc = tid + i * NTHR, kk = pc >> 6, c4 = (pc & 63) * 4; float* d = tile + kk * 257 + c4; d[0] = v[i].x; d[1] = v[i].y; d[2] = v[i].z; d[3] = v[i].w; }
        const int itn = it + nvb;
        if (itn < nitems) { const int k0n = 64 * (itn / nblk), n0n = 256 * (itn % nblk);
#pragma unroll
            for (int i = 0; i < 8; ++i) { const int pc = tid + i * NTHR, kk = pc >> 6, c4 = (pc & 63) * 4; v[i] = __builtin_nontemporal_load((const f32x4*)(W + (size_t)(k0n + kk) * ldw + n0n + c4)); } }
        __syncthreads();
        const int n = tid & 255, kh = (tid >> 8) * 32; const float* sp = tile + kh * 257 + n; bf16* o = WT + (size_t)(n0 + n) * K + k0 + kh;
#pragma unroll
        for (int q = 0; q < 4; ++q) { u32x4 w; w.x = pk2(sp[(8 * q) * 257], sp[(8 * q + 1) * 257]); w.y = pk2(sp[(8 * q + 2) * 257], sp[(8 * q + 3) * 257]); w.z = pk2(sp[(8 * q + 4) * 257], sp[(8 * q + 5) * 257]); w.w = pk2(sp[(8 * q + 6) * 257], sp[(8 * q + 7) * 257]);
            *(u32x4*)(o + 8 * q) = w; }
    }
    __syncthreads();
}
__device__ __forceinline__ void hartley_fold(const float* W  , bf16* WT, unsigned char* lds) {
    float* tile = (float*)lds;
    float* cas = tile + 64 * 257;
    const int tid = tidx();
    for (int it = blockIdx.x; it < 16 * 32; it += gridDim.x) {
        const int g = it >> 5, k0 = (it & 31) * 64;
        __syncthreads();
        { f32x4 v[8];
#pragma unroll
          for (int i = 0; i < 8; ++i) { const int pc = tid + i * NTHR, kk = pc >> 6, c4 = (pc & 63) * 4; v[i] = __builtin_nontemporal_load((const f32x4*)(W + (size_t)(k0 + kk) * 8192 + g * 256 + c4)); }
#pragma unroll
          for (int i = 0; i < 8; ++i) { const int pc = tid + i * NTHR, kk = pc >> 6, c4 = (pc & 63) * 4; float* d = tile + kk * 257 + c4; d[0] = v[i].x; d[1] = v[i].y; d[2] = v[i].z; d[3] = v[i].w; } }
        if (tid < 256) { const float t = (float)tid * (1.f / 256.f); cas[tid] = __builtin_amdgcn_cosf(t) + __builtin_amdgcn_sinf(t); }
        __syncthreads();
        const int l0 = tid & 63, kg = (tid >> 6) * 8;
        float acc[8][4];
#pragma unroll
        for (int kk = 0; kk < 8; ++kk)
#pragma unroll
            for (int jj = 0; jj < 4; ++jj) acc[kk][jj] = 0.f;
#pragma unroll 2
        for (int cc = 0; cc < 256; ++cc) { float w[4];
#pragma unroll
            for (int jj = 0; jj < 4; ++jj) w[jj] = cas[((l0 + 64 * jj) * cc) & 255];
#pragma unroll
            for (int kk = 0; kk < 8; ++kk) { const float tv = tile[(kg + kk) * 257 + cc];
#pragma unroll
                for (int jj = 0; jj < 4; ++jj) acc[kk][jj] += tv * w[jj]; } }
#pragma unroll
        for (int jj = 0; jj < 4; ++jj) { u32x4 w; w.x = pk2(acc[0][jj], acc[1][jj]); w.y = pk2(acc[2][jj], acc[3][jj]); w.z = pk2(acc[4][jj], acc[5][jj]); w.w = pk2(acc[6][jj], acc[7][jj]);
            *(u32x4*)(WT + (size_t)(g * 256 + l0 + 64 * jj) * 2048 + k0 + kg) = w; }
    }
    __syncthreads();
}
__device__ __forceinline__ void norm_rows(const Params& p, int L, int nrows, bool perm) {
    const int lane = tidx() & 63, gw = blockIdx.x * NWAVES + (tidx() >> 6), NGW = gridDim.x * NWAVES;
    const float* gvec = p.in[4] + L * 2048; const float* mod = (const float*)(p.ws + WS_MOD) + (size_t)L * 3 * 6144;
    bf16* HB = (bf16*)(p.ws + WS_HB);
    const float* xl = L == 0 ? p.in[0] : p.out; const float* xcx = L <= 1 ? p.in[2] : (const float*)(p.ws + WS_XC);
#define NR_SRC(r) ((r) < ML ? xl + (size_t)(r) * DM : xcx + (size_t)((r) - ML) * DM)
    f32x4 x[8], xn[8];
    int row = gw;
    if (row < nrows) { const float* xr = NR_SRC(row);
#pragma unroll
        for (int j = 0; j < 8; ++j) x[j] = *(const f32x4*)(xr + 4 * lane + 256 * j); }
    for (; row < nrows; row += NGW) {
        const int rn = row + NGW;
        if (rn < nrows) { const float* xr = NR_SRC(rn);
#pragma unroll
            for (int j = 0; j < 8; ++j) xn[j] = *(const f32x4*)(xr + 4 * lane + 256 * j); }
        const int v = row < ML ? (row >> 13) : 2; const float* sh = mod + v * 6144; const float* sc = sh + 2048;
        const int orow = (perm && row < ML) ? ((row & ~8191) + ((row & 63) << 7) + ((row & 8191) >> 6)) : row;
        bool emit = true;
        if (row >= ML && L >= 1) {
            const float* gp = mod - 3 * 6144 + 2 * 6144 + 4096; const float* pp = (const float*)(p.ws + WS_PART) + (size_t)(row - ML) * 2048; float* xw = (float*)(p.ws + WS_XC) + (size_t)(row - ML) * DM;
#pragma unroll
            for (int j = 0; j < 8; ++j) { const int c0 = 4 * lane + 256 * j; f32x4 a = *(const f32x4*)(pp + c0);
#pragma unroll
                for (int ks = 1; ks < 8; ++ks) a = a + *(const f32x4*)(pp + (size_t)ks * 512 * 2048 + c0);
                x[j] = x[j] + *(const f32x4*)(gp + c0) * a; *(f32x4*)(xw + c0) = x[j];
                asm volatile("" ::: "memory"); }
            emit = L != 3;
        }
        if (emit) {
            float s = 0.f;
#pragma unroll
            for (int j = 0; j < 8; ++j) s += (x[j].x * x[j].x + x[j].y * x[j].y) + (x[j].z * x[j].z + x[j].w * x[j].w);
            const float rstd = rsqrtf(wave_sum(s) * (1.f / DM) + EPS);
#pragma unroll
            for (int j = 0; j < 8; ++j) { const int c0 = 4 * lane + 256 * j; const f32x4 g4 = *(const f32x4*)(gvec + c0), s4 = *(const f32x4*)(sc + c0), h4 = *(const f32x4*)(sh + c0);
                const f32x4 y = x[j] * rstd * g4 * (1.f + s4) + h4; u32x2 w; w.x = pk2(y.x, y.y); w.y = pk2(y.z, y.w); *(u32x2*)(HB + (size_t)orow * DM + c0) = w; }
        }
#pragma unroll
        for (int j = 0; j < 8; ++j) x[j] = xn[j];
    }
#undef NR_SRC
}
template <int L> __device__ __forceinline__ void phase_prep(const Params& p, unsigned char* lds) {
    constexpr int kind = L % 3, j = L / 3;
    bf16* WIN = (bf16*)(p.ws + WS_WIN); bf16* WOUT = (bf16*)(p.ws + WS_WOUT);
    if (kind == 0) { const float* W = p.in[8] + (size_t)j * 2048 * 8192;
        hartley_fold(W, WIN, lds);
        transpose_all(W + 4096, 8192, 2048, 4096, WIN + (size_t)4096 * 2048, lds);
        { const float* wmix = p.in[9] + (size_t)j * 16 * 65536; bf16* BM = (bf16*)(p.ws + WS_BMIX);
          for (int base = blockIdx.x * NTHR + tidx(); base < 16 * 256 * 512; base += 8 * gridDim.x * NTHR) { float v[8];
#pragma unroll
              for (int e = 0; e < 8; ++e) { const int idx = base + e * gridDim.x * NTHR; const int jj = idx & 511, d = (idx >> 9) & 255, g = idx >> 17, l = jj < 256 ? jj : ((512 - jj) & 255);
                  v[e] = idx < 16 * 256 * 512 ? wmix[(size_t)g * 65536 + l * 256 + d] : 0.f; }
#pragma unroll
              for (int e = 0; e < 8; ++e) { const int idx = base + e * gridDim.x * NTHR; if (idx < 16 * 256 * 512) BM[idx] = (bf16)f2bf(v[e]); } } }
    } else if (kind == 1) transpose_all(p.in[10], 9216, 2048, 9216, WIN, lds);
    else { transpose_all(p.in[12], 12288, 2048, 12288, WIN, lds);
        bf16* WSB = (bf16*)(p.ws + WS_WSB); const float* wsp = p.in[13];
        for (int idx = blockIdx.x * NTHR + tidx(); idx < 16 * 128 * 128; idx += gridDim.x * NTHR) WSB[idx] = (bf16)f2bf(wsp[idx]); }
    transpose_all(p.in[7] + (size_t)L * 4096 * 2048, 2048, 4096, 2048, WOUT, lds);
    norm_rows(p, L, MT, kind == 0);
}

struct SchedCtxOut : pg8::StaticOrder {
    const char* A0; const char* B0;
    __device__ __forceinline__ const char* aptr(const pg8::Unit& u) const { return A0 + (size_t)u.pm * (256 * 4096 * 2) + (u.pn >> 3) * 1024; }
    __device__ __forceinline__ const char* bptr(const pg8::Unit& u) const { return B0 + (size_t)(u.pn & 7) * (256 * 4096 * 2) + (u.pn >> 3) * 1024; }
};
template <int L> __device__ __forceinline__ void phase_outproj(const Params& p, unsigned char* lds) {
    const unsigned char* Y = p.ws + (L % 3 == 0 ? WS_YB_F : (L % 3 == 1 ? WS_YB : WS_UG));
    { pg8::Gemm g{DBR, DBR, DBR};
      SchedLin S; S.init(ML, DM, gridDim.x, blockIdx.x); S.plain(Y, DBR, p.ws + WS_WOUT, DBR);
      pg8::EpiResid E{L == 0 ? p.in[0] : p.out, p.out, (const float*)(p.ws + WS_MOD) + (size_t)L * 3 * 6144};
      pg8::gemm_phase<pg8::EpiResid, SchedLin>((PG8_LAS unsigned char*)lds, g, S, E); }
    if (L < 3) {
        pg8::Gemm g{DBR, DBR, 512};
        SchedCtxOut S; S.init(MC, 64 * 256, gridDim.x, blockIdx.x); S.A0 = (const char*)(Y + (size_t)ML * DBR * 2); S.B0 = (const char*)(p.ws + WS_WOUT);
        pg8::EpiPart E{(float*)(p.ws + WS_PART)};
        pg8::gemm_phase<pg8::EpiPart, SchedCtxOut>((PG8_LAS unsigned char*)lds, g, S, E);
    }
}

using pg8::Unit;
__device__ __forceinline__ u32x4 pack8(const pg8::f32x4& a, const pg8::f32x4& b) { u32x4 w; w.x = pg8::cvt_pk_bf16(a[0], a[1]); w.y = pg8::cvt_pk_bf16(a[2], a[3]); w.z = pg8::cvt_pk_bf16(b[0], b[1]); w.w = pg8::cvt_pk_bf16(b[2], b[3]); return w; }
struct SchedFnetIn : pg8::StaticOrder {
    const char* HBp; const char* WINp;
    __device__ __forceinline__ const char* aptr(const Unit& u) const { return (u.pn < 16 ? WINp + (size_t)u.pn * (256 * 2048 * 2) : HBp + (size_t)u.pm * (256 * 2048 * 2)) + (size_t)u.roff * (2048 * 2); }
    __device__ __forceinline__ const char* bptr(const Unit& u) const { return u.pn < 16 ? HBp + (size_t)u.pm * (256 * 2048 * 2) : WINp + (size_t)u.pn * (256 * 2048 * 2); }
};
struct EpiFnetIn {
    static constexpr bool PERM = true;
    unsigned char* ws;
    __device__ __forceinline__ void operator()(const pg8::f32x4 (&acc)[2][2][4][2], const Unit& u, int wr, int wc, int fr, int fq) const {
        bf16* const U1 = (bf16*)(ws + WS_U1); bf16* const UCT = (bf16*)(ws + WS_UCT); bf16* const ZB = (bf16*)(ws + WS_ZB);
        { int t_ = tidx(); fr = t_ & 15; fq = (t_ >> 4) & 3; }
        if (u.pn < 16) {
#pragma unroll
            for (int ai = 0; ai < 2; ++ai)
#pragma unroll
                for (int m = 0; m < 4; ++m) { if (ai >= u.na) break; const int c = u.pn * 256 + u.roff + ai * 128 + wr * 64 + m * 16 + fr;
#pragma unroll
                    for (int bj = 0; bj < 2; ++bj) { const int tcol = bj * 128 + wc * 32 + 8 * fq; bf16* dst;
                        if (u.pm < 64) { const int rp = u.pm * 256 + tcol, b = rp >> 13, r = rp & 8191, n2 = r >> 7, n1 = r & 127; dst = U1 + ((size_t)(b * 4096 + c) * 64 + n2) * 128 + n1; }
                        else dst = UCT + ((size_t)((u.pm - 64) * 4096 + c) * 256 + tcol);
                        *(u32x4*)dst = pack8(acc[ai][bj][m][0], acc[ai][bj][m][1]); } }
        } else {
#pragma unroll
            for (int ai = 0; ai < 2; ++ai)
#pragma unroll
                for (int m = 0; m < 4; ++m) { if (ai >= u.na) break; const int rp = u.pm * 256 + u.roff + ai * 128 + wr * 64 + m * 16 + fr; int row = rp;
                    if (rp < ML) { const int r = rp & 8191; row = (rp & ~8191) + ((r & 127) << 6) + (r >> 7); }
#pragma unroll
                    for (int bj = 0; bj < 2; ++bj) { const int zc = (u.pn - 16) * 256 + bj * 128 + wc * 32 + 8 * fq; pg8::f32x4 a = acc[ai][bj][m][0], b = acc[ai][bj][m][1];
#pragma unroll
                        for (int e = 0; e < 4; ++e) { a[e] = silu_f(a[e]); b[e] = silu_f(b[e]); }
                        *(u32x4*)(ZB + (size_t)row * 4096 + zc) = pack8(a, b); } }
        }
    }
};
template <int L> __device__ __forceinline__ void phase_inproj_fnet(const Params& p, unsigned char* lds) {
    constexpr int M = L == 3 ? ML : MT;
    pg8::Gemm g{DM, DM, DM};
    SchedFnetIn S; S.init(M, 8192, gridDim.x, blockIdx.x, true); S.HBp = (const char*)(p.ws + WS_HB); S.WINp = (const char*)(p.ws + WS_WIN);
    EpiFnetIn E{p.ws};
    pg8::gemm_phase<EpiFnetIn, SchedFnetIn>((PG8_LAS unsigned char*)lds, g, S, E);
}
struct EpiStageA {
    static constexpr bool PERM = true;
    bf16* YP;
    __device__ __forceinline__ void operator()(const pg8::f32x4 (&acc)[2][2][4][2], const Unit& u, int wr, int wc, int fr, int fq) const {
        { int t_ = tidx(); fr = t_ & 15; fq = (t_ >> 4) & 3; }
#pragma unroll
        for (int m = 0; m < 4; ++m) { const int k1 = wr * 64 + m * 16 + fr;
#pragma unroll
            for (int bj = 0; bj < 2; ++bj) { const int idx = u.pn * 256 + bj * 128 + wc * 32 + 8 * fq, n2 = idx & 63, c = (idx >> 6) & 4095, b = idx >> 18;
                bf16* dst = YP + ((((size_t)(b * 128 + k1) * 4096 + c) * 64 + n2) << 1);
#pragma unroll
                for (int h = 0; h < 2; ++h) { const pg8::f32x4 re = acc[0][bj][m][h], im = acc[1][bj][m][h];
                    u32x4 w; w.x = pg8::cvt_pk_bf16(re[0], im[0]); w.y = pg8::cvt_pk_bf16(re[1], im[1]); w.z = pg8::cvt_pk_bf16(re[2], im[2]); w.w = pg8::cvt_pk_bf16(re[3], im[3]);
                    *(u32x4*)(dst + 8 * h) = w; } } }
    }
};
struct EpiCtxH {
    static constexpr bool PERM = true;
    bf16* TO;
    __device__ __forceinline__ void operator()(const pg8::f32x4 (&acc)[2][2][4][2], const Unit& u, int wr, int wc, int fr, int fq) const {
        { int t_ = tidx(); fr = t_ & 15; fq = (t_ >> 4) & 3; }
        const int b = u.pn >> 4, g = u.pn & 15;
#pragma unroll
        for (int ai = 0; ai < 2; ++ai)
#pragma unroll
            for (int m = 0; m < 4; ++m) { const int k = ai * 128 + wr * 64 + m * 16 + fr;
#pragma unroll
                for (int bj = 0; bj < 2; ++bj) { const int l = bj * 128 + wc * 32 + 8 * fq;
                    *(u32x4*)(TO + ((size_t)(ML + b * 256 + k) * 16 + g) * 512 + u.pm * 256 + l) = pack8(acc[ai][bj][m][0], acc[ai][bj][m][1]); } }
    }
};
__device__ __forceinline__ void phase_fnet_a(const Params& p, bool ctx, unsigned char* lds) {
    if (ctx) {
        pg8::Gemm g{256, 256, 256};
        SchedLin S; S.init(512, 8192, gridDim.x, blockIdx.x); S.A0 = (const char*)(p.ws + TAB_CASPM); S.B0 = (const char*)(p.ws + WS_UCT); S.sAm = 256 * 256 * 2; S.sAn = 0; S.sBm = 0; S.sBn = 256 * 256 * 2;
        EpiCtxH E{(bf16*)(p.ws + WS_TO)};
        pg8::gemm_phase<EpiCtxH, SchedLin>((PG8_LAS unsigned char*)lds, g, S, E);
    }
    pg8::Gemm g{128, 128, 128};
    SchedLin S; S.init(256, 2 * 4096 * 64, gridDim.x, blockIdx.x); S.A0 = (const char*)(p.ws + TAB_DA); S.B0 = (const char*)(p.ws + WS_U1); S.sAm = 0; S.sAn = 0; S.sBm = 0; S.sBn = 256 * 128 * 2;
    EpiStageA E{(bf16*)(p.ws + WS_YP)};
    pg8::gemm_phase<EpiStageA, SchedLin>((PG8_LAS unsigned char*)lds, g, S, E);
}
struct EpiStageC {
    static constexpr bool PERM = true;
    bf16* TO;
    __device__ __forceinline__ void operator()(const pg8::f32x4 (&acc)[2][2][4][2], const Unit& u, int wr, int wc, int fr, int fq) const {
        { int t_ = tidx(); fr = t_ & 15; fq = (t_ >> 4) & 3; }
        const int idx = u.pn * 256, g = (idx & 4095) >> 8, k1 = (idx >> 12) & 127, b = idx >> 19;
#pragma unroll
        for (int m = 0; m < 4; ++m) { const int k2 = m * 16 + fr; const size_t row = (size_t)b * 8192 + k1 + 128 * k2;
#pragma unroll
            for (int bj = 0; bj < 2; ++bj) { const int l = bj * 128 + wc * 32 + 8 * fq;
                *(u32x4*)(TO + (row * 16 + g) * 512 + wr * 256 + l) = pack8(acc[0][bj][m][0], acc[0][bj][m][1]); } }
    }
};
struct SchedStageC : pg8::StaticOrder {
    const char* A0; const char* B0; size_t sBn;
    __device__ __forceinline__ const char* aptr(const Unit& u) const { return A0 + (size_t)((u.pn >> 4) & 127) * (128 * 128 * 2); }
    __device__ __forceinline__ const char* bptr(const Unit& u) const { return B0 + u.pn * sBn; }
};
__device__ __forceinline__ void phase_fnet_c(const Params& p, unsigned char* lds) {
    pg8::Gemm g{128, 128, 128};
    SchedStageC S; S.init(256, 2 * 128 * 4096, gridDim.x, blockIdx.x); S.A0 = (const char*)(p.ws + TAB_DC2); S.B0 = (const char*)(p.ws + WS_YP); S.sBn = 256 * 128 * 2;
    EpiStageC E{(bf16*)(p.ws + WS_TO)};
    pg8::gemm_phase<EpiStageC, SchedStageC, true>((PG8_LAS unsigned char*)lds, g, S, E);
}
struct EpiMix {
    static constexpr bool PERM = true;
    const bf16* ZB; bf16* YB;
    __device__ __forceinline__ void operator()(const pg8::f32x4 (&acc)[2][2][4][2], const Unit& u, int wr, int wc, int fr, int fq) const {
        { int t_ = tidx(); fr = t_ & 15; fq = (t_ >> 4) & 3; }
#pragma unroll
        for (int ai = 0; ai < 2; ++ai) {
            if (ai >= u.na) break;
            u32x4 zv[4][2];
#pragma unroll
            for (int m = 0; m < 4; ++m)
#pragma unroll
                for (int bj = 0; bj < 2; ++bj) zv[m][bj] = *(const u32x4*)(ZB + (size_t)(u.pm * 256 + u.roff + ai * 128 + wr * 64 + m * 16 + fr) * 4096 + u.pn * 256 + bj * 128 + wc * 32 + 8 * fq);
#pragma unroll
            for (int m = 0; m < 4; ++m) { const int row = u.pm * 256 + u.roff + ai * 128 + wr * 64 + m * 16 + fr; const float sc = row < ML ? 0.5f * 6.9053396600248786e-4f : 0.5f / 256.f;
#pragma unroll
                for (int bj = 0; bj < 2; ++bj) { const size_t off = (size_t)row * 4096 + u.pn * 256 + bj * 128 + wc * 32 + 8 * fq;
                    const u32x4 z = zv[m][bj]; pg8::f32x4 a = acc[ai][bj][m][0] * sc, b = acc[ai][bj][m][1] * sc;
                    a[0] *= __uint_as_float(z.x << 16); a[1] *= __uint_as_float(z.x & 0xffff0000u); a[2] *= __uint_as_float(z.y << 16); a[3] *= __uint_as_float(z.y & 0xffff0000u);
                    b[0] *= __uint_as_float(z.z << 16); b[1] *= __uint_as_float(z.z & 0xffff0000u); b[2] *= __uint_as_float(z.w << 16); b[3] *= __uint_as_float(z.w & 0xffff0000u);
                    *(u32x4*)(YB + off) = pack8(a, b); } }
            asm volatile("" ::: "memory");
        }
    }
};
template <int L> __device__ __forceinline__ void phase_fnet_mix(const Params& p, unsigned char* lds) {
    constexpr int M = L == 3 ? ML : MT;
    pg8::Gemm g{8192, 512, 512};
    SchedLin S; S.init(M, 4096, gridDim.x, blockIdx.x, true); S.A0 = (const char*)(p.ws + WS_TO); S.B0 = (const char*)(p.ws + WS_BMIX); S.sAm = (size_t)256 * 8192 * 2; S.sAn = 512 * 2; S.sBm = 0; S.sBn = 256 * 512 * 2;
    EpiMix E{(const bf16*)(p.ws + WS_ZB), (bf16*)(p.ws + WS_YB_F)};
    pg8::gemm_phase<EpiMix, SchedLin>((PG8_LAS unsigned char*)lds, g, S, E);
}

struct SchedAttnIn : pg8::StaticOrder {
    const char* HBp; const char* WINp;
    __device__ __forceinline__ const char* aptr(const Unit& u) const { return ((u.pn == 18 || u.pn == 19) ? WINp + (size_t)u.pn * (256 * 2048 * 2) : HBp + (size_t)u.pm * (256 * 2048 * 2)) + (size_t)u.roff * (2048 * 2); }
    __device__ __forceinline__ const char* bptr(const Unit& u) const { return (u.pn == 18 || u.pn == 19) ? HBp + (size_t)u.pm * (256 * 2048 * 2) : WINp + (size_t)u.pn * (256 * 2048 * 2); }
};
__device__ __forceinline__ u32x2 pack4(const pg8::f32x4& a) { u32x2 w; w.x = pg8::cvt_pk_bf16(a[0], a[1]); w.y = pg8::cvt_pk_bf16(a[2], a[3]); return w; }
struct EpiAttnIn {
    static constexpr bool PERM = false;
    unsigned char* ws;
    __device__ __forceinline__ void operator()(const pg8::f32x4 (&acc)[2][2][4][2], const Unit& u, int wr, int wc, int fr, int fq) const {
        { int t_ = tidx(); fr = t_ & 15; fq = (t_ >> 4) & 3; }
        if (u.pn < 18) {
            const bool isq = u.pn < 16; bf16* const O = isq ? (bf16*)(ws + WS_QB) : (bf16*)(ws + WS_KB); const int ldo = isq ? 4096 : 512; const int cb = (isq ? u.pn : u.pn - 16) * 256 + wc * 32 + 4 * fq;
            const float sc = isq ? 0.125f * 1.4426950408889634f : 1.f; const float* rope = (const float*)(ws + TAB_ROPE);
#pragma unroll
            for (int ai = 0; ai < 2; ++ai)
#pragma unroll
                for (int m = 0; m < 4; ++m) { if (ai >= u.na) break; const int row = u.pm * 256 + u.roff + ai * 128 + wr * 64 + m * 16 + fr;
                    pg8::f32x4 c4 = (pg8::f32x4){1.f, 1.f, 1.f, 1.f}, s4 = (pg8::f32x4){0.f, 0.f, 0.f, 0.f};
                    if (row < ML) { const int t = row & 8191, pos = (wc & 1) ? (t & 63) : (t >> 6); const pg8::f32x4 r0 = *(const pg8::f32x4*)(rope + 2 * (pos * 16 + 4 * fq)), r1 = *(const pg8::f32x4*)(rope + 2 * (pos * 16 + 4 * fq) + 4);
                        c4 = (pg8::f32x4){r0[0], r0[2], r1[0], r1[2]}; s4 = (pg8::f32x4){r0[1], r0[3], r1[1], r1[3]}; }
#pragma unroll
                    for (int bj = 0; bj < 2; ++bj) { const pg8::f32x4 x1 = acc[ai][bj][m][0], x2 = acc[ai][bj][m][1];
                        const pg8::f32x4 y1 = (x1 * c4 - x2 * s4) * sc, y2 = (x1 * s4 + x2 * c4) * sc; bf16* o = O + (size_t)row * ldo + cb + bj * 128;
                        *(u32x2*)o = pack4(y1); *(u32x2*)(o + 16) = pack4(y2); }
                    if (m == 3) asm volatile("" ::: "memory"); }
        } else if (u.pn < 20) {
#pragma unroll
            for (int ai = 0; ai < 2; ++ai)
#pragma unroll
                for (int m = 0; m < 4; ++m) { if (ai >= u.na) break; const int ch = (u.pn - 18) * 256 + u.roff + ai * 128 + wr * 64 + m * 16 + fr;
#pragma unroll
                    for (int bj = 0; bj < 2; ++bj)
#pragma unroll
                        for (int n = 0; n < 2; ++n) { const int tcol = bj * 128 + wc * 32 + n * 16 + 4 * fq; bf16* dst;
                            if (u.pm < 64) { const int tk = u.pm * 256 + tcol; dst = (bf16*)(ws + WS_VT) + ((size_t)((tk >> 13) * 512 + ch) * 8192 + (tk & 8191)); }
                            else dst = (bf16*)(ws + WS_VTC) + ((size_t)((u.pm - 64) * 512 + ch) * 256 + tcol);
                            *(u32x2*)dst = pack4(acc[ai][bj][m][n]); } }
        } else {
            bf16* const ZB = (bf16*)(ws + WS_ZA);
#pragma unroll
            for (int ai = 0; ai < 2; ++ai)
#pragma unroll
                for (int m = 0; m < 4; ++m) { if (ai >= u.na) break; const int row = u.pm * 256 + u.roff + ai * 128 + wr * 64 + m * 16 + fr;
#pragma unroll
                    for (int bj = 0; bj < 2; ++bj)
#pragma unroll
                        for (int n = 0; n < 2; ++n) { pg8::f32x4 a = acc[ai][bj][m][n];
#pragma unroll
                            for (int e = 0; e < 4; ++e) a[e] = silu_f(a[e]);
                            *(u32x2*)(ZB + (size_t)row * 4096 + (u.pn - 20) * 256 + bj * 128 + wc * 32 + n * 16 + 4 * fq) = pack4(a); } }
        }
    }
};
__device__ __forceinline__ void phase_inproj_attn(const Params& p, unsigned char* lds) {
    pg8::Gemm g{DM, DM, DM};
    SchedAttnIn S; S.init(MT, 9216, gridDim.x, blockIdx.x, true); S.HBp = (const char*)(p.ws + WS_HB); S.WINp = (const char*)(p.ws + WS_WIN);
    EpiAttnIn E{p.ws};
    pg8::gemm_phase<EpiAttnIn, SchedAttnIn>((PG8_LAS unsigned char*)lds, g, S, E);
}
typedef short bf16x8_t __attribute__((ext_vector_type(8)));
typedef float f32x16 __attribute__((ext_vector_type(16)));
#define MFMA32(a, b, c) __builtin_amdgcn_mfma_f32_32x32x16_bf16((a), (b), (c), 0, 0, 0)
__device__ __forceinline__ bf16x8_t pack_step(const f32x16& x, int s) {
    u32x4 q;
    asm volatile("s_nop 3\n\tv_cvt_pk_bf16_f32 %0, %4, %5\n\tv_cvt_pk_bf16_f32 %1, %6, %7\n\tv_cvt_pk_bf16_f32 %2, %8, %9\n\tv_cvt_pk_bf16_f32 %3, %10, %11\n\ts_nop 1"
                 : "=&v"(q[0]), "=&v"(q[1]), "=&v"(q[2]), "=&v"(q[3])
                 : "v"(x[8 * s]), "v"(x[8 * s + 1]), "v"(x[8 * s + 2]), "v"(x[8 * s + 3]), "v"(x[8 * s + 4]), "v"(x[8 * s + 5]), "v"(x[8 * s + 6]), "v"(x[8 * s + 7]));
    return __builtin_bit_cast(bf16x8_t, q);
}
__device__ __forceinline__ void phase_attn(const Params& p, unsigned char* lds) {
    const int tid = tidx(), lane = tid & 63, wave = __builtin_amdgcn_readfirstlane(tid >> 6), r = lane & 31, h = lane >> 5;
    const bf16* QB = (const bf16*)(p.ws + WS_QB); const bf16* KB = (const bf16*)(p.ws + WS_KB); const bf16* VT = (const bf16*)(p.ws + WS_VT); const bf16* VTC = (const bf16*)(p.ws + WS_VTC);
    const bf16* ZB = (const bf16*)(p.ws + WS_ZA); bf16* YB = (bf16*)(p.ws + WS_YB); const float* sink = p.in[11];
    const int sk = tid >> 3, sp = tid & 7;
    constexpr int BUF = 18432, VOFF = 9216, RS = 144;
    for (int item = blockIdx.x; item < 2112; item += gridDim.x) {
        int b, kvh, q0, qrow0, cfirst, nw;
        if (item < 2048) { b = item >> 10; kvh = (item >> 7) & 7; q0 = (item & 127) * 64; qrow0 = b * 8192 + q0;
            cfirst = q0 < 128 ? (128 - q0) >> 6 : 0; const int clast = q0 > 8000 ? (8256 - q0) >> 6 : 4; nw = clast - cfirst + 1; }
        else { const int i2 = item - 2048; b = i2 >> 5; kvh = (i2 >> 2) & 7; q0 = (i2 & 3) * 64; qrow0 = ML + b * 256 + q0; cfirst = 0; nw = 0; }
        const int nch = nw + 4, hq = kvh * 8 + wave;
        bf16x8_t Qf[2][4];
#pragma unroll
        for (int sb = 0; sb < 2; ++sb)
#pragma unroll
            for (int st = 0; st < 4; ++st) Qf[sb][st] = *(const bf16x8_t*)((const char*)QB + (size_t)(unsigned)(((qrow0 + sb * 32 + r) * 4096 + hq * 64 + 16 * st + 8 * h) * 2));
        float mrun[2], lrun[2]; f32x16 O[2][2];
#pragma unroll
        for (int sb = 0; sb < 2; ++sb) { mrun[sb] = sink[hq] * 1.4426950408889634f; lrun[sb] = h == 0 ? 1.f : 0.f;
#pragma unroll
            for (int dt = 0; dt < 2; ++dt)
#pragma unroll
                for (int i = 0; i < 16; ++i) O[sb][dt][i] = 0.f; }
        u32x4 kreg, vreg;
#define ATT_SRC(j, kp_, vp_) do { if ((j) < nw) { const int kpos0_ = q0 - 128 + 64 * (cfirst + (j)); kp_ = (const char*)KB + (size_t)(unsigned)((((b * 8192 + kpos0_ + sk) * 512) + kvh * 64 + sp * 8) * 2); vp_ = (const char*)VT + (size_t)(unsigned)((((b * 512 + kvh * 64 + sk) * 8192) + kpos0_ + sp * 8) * 2); } \
        else { const int kc = 64 * ((j) - nw); kp_ = (const char*)KB + (size_t)(unsigned)((((ML + b * 256 + kc + sk) * 512) + kvh * 64 + sp * 8) * 2); vp_ = (const char*)VTC + (size_t)(unsigned)((((b * 512 + kvh * 64 + sk) * 256) + kc + sp * 8) * 2); } } while (0)
        { const char* kp; const char* vp; ATT_SRC(0, kp, vp); kreg = *(const u32x4*)kp; vreg = *(const u32x4*)vp;
          *(u32x4*)(lds + sk * RS + sp * 16) = kreg; *(u32x4*)(lds + VOFF + sk * RS + sp * 16) = vreg; }
        __syncthreads();
        for (int j = 0; j < nch; ++j) {
            const bool more = j + 1 < nch;
            if (more) { const char* kp; const char* vp; ATT_SRC(j + 1, kp, vp); kreg = *(const u32x4*)kp; vreg = *(const u32x4*)vp; }
            const unsigned char* Kb = lds + (j & 1) * BUF; const unsigned char* Vb = Kb + VOFF;
            const int cw = cfirst + j; const bool mlo = (j < nw) && cw == 0, mhi = (j < nw) && cw == 4; const int kpos0 = q0 - 128 + 64 * cw;
            f32x16 sc[2][2];
#pragma unroll
            for (int sb = 0; sb < 2; ++sb) {
#pragma unroll
                for (int i = 0; i < 16; ++i) { sc[sb][0][i] = 0.f; sc[sb][1][i] = 0.f; }
#pragma unroll
                for (int st = 0; st < 4; ++st) { const bf16x8_t k0 = *(const bf16x8_t*)(Kb + r * RS + (16 * st + 8 * h) * 2), k1 = *(const bf16x8_t*)(Kb + (32 + r) * RS + (16 * st + 8 * h) * 2);
                    sc[sb][0] = MFMA32(k0, Qf[sb][st], sc[sb][0]); sc[sb][1] = MFMA32(k1, Qf[sb][st], sc[sb][1]); }
            }
#pragma unroll
            for (int sb = 0; sb < 2; ++sb) {
                f32x16& s0 = sc[sb][0]; f32x16& s1 = sc[sb][1];
                if (mlo || mhi) { const int qpos = q0 + sb * 32 + r, lo_t = mlo ? qpos - 128 : -(1 << 30), hi_t = mhi ? qpos + 128 : (1 << 30);
#pragma unroll
                    for (int i = 0; i < 16; ++i) { const int kp0 = kpos0 + (i & 3) + 8 * (i >> 2) + 4 * h, kp1 = kp0 + 32;
                        s0[i] = (kp0 < lo_t || kp0 > hi_t) ? -1e30f : s0[i]; s1[i] = (kp1 < lo_t || kp1 > hi_t) ? -1e30f : s1[i]; } }
                float mx = fmaxf(s0[0], s1[0]);
#pragma unroll
                for (int i = 1; i < 16; ++i) mx = fmaxf(mx, fmaxf(s0[i], s1[i]));
                mx = fmaxf(mx, __shfl_xor(mx, 32));
                const float mn = fmaxf(mrun[sb], mx), al = __builtin_amdgcn_exp2f(mrun[sb] - mn); mrun[sb] = mn;
                float rs = 0.f;
#pragma unroll
                for (int i = 0; i < 16; ++i) { s0[i] = __builtin_amdgcn_exp2f(s0[i] - mn); s1[i] = __builtin_amdgcn_exp2f(s1[i] - mn); rs += s0[i] + s1[i]; }
                lrun[sb] = lrun[sb] * al + rs;
#pragma unroll
                for (int dt = 0; dt < 2; ++dt)
#pragma unroll
                    for (int i = 0; i < 16; ++i) O[sb][dt][i] *= al;
#pragma unroll
                for (int kt = 0; kt < 2; ++kt)
#pragma unroll
                    for (int st = 0; st < 2; ++st) { const bf16x8_t pf = pack_step(kt ? s1 : s0, st);
#pragma unroll
                        for (int dt = 0; dt < 2; ++dt) { const unsigned char* va = Vb + (32 * dt + r) * RS + (32 * kt + 16 * st + 4 * h) * 2;
                            const u32x2 v0 = *(const u32x2*)va, v1 = *(const u32x2*)(va + 16); u32x4 vv; vv.x = v0.x; vv.y = v0.y; vv.z = v1.x; vv.w = v1.y;
                            O[sb][dt] = MFMA32(__builtin_bit_cast(bf16x8_t, vv), pf, O[sb][dt]); } }
            }
            if (more) { unsigned char* nb = lds + ((j + 1) & 1) * BUF; *(u32x4*)(nb + sk * RS + sp * 16) = kreg; *(u32x4*)(nb + VOFF + sk * RS + sp * 16) = vreg; }
            __syncthreads();
        }
#undef ATT_SRC
        u32x2 zv[2][2][4];
#pragma unroll
        for (int sb = 0; sb < 2; ++sb) { const unsigned rowoff = (unsigned)((qrow0 + sb * 32 + r) * 4096 + hq * 64);
#pragma unroll
            for (int dt = 0; dt < 2; ++dt)
#pragma unroll
                for (int g4 = 0; g4 < 4; ++g4) zv[sb][dt][g4] = *(const u32x2*)(ZB + (size_t)(rowoff + 32 * dt + 8 * g4 + 4 * h)); }
#pragma unroll
        for (int sb = 0; sb < 2; ++sb) { const float lt = lrun[sb] + __shfl_xor(lrun[sb], 32), il = __builtin_amdgcn_rcpf(lt); const unsigned rowoff = (unsigned)((qrow0 + sb * 32 + r) * 4096 + hq * 64);
#pragma unroll
            for (int dt = 0; dt < 2; ++dt)
#pragma unroll
                for (int g4 = 0; g4 < 4; ++g4) { const size_t off = (size_t)(rowoff + 32 * dt + 8 * g4 + 4 * h); const u32x2 z = zv[sb][dt][g4];
                    const float y0 = O[sb][dt][4 * g4 + 0] * il * __uint_as_float(z.x << 16), y1 = O[sb][dt][4 * g4 + 1] * il * __uint_as_float(z.x & 0xffff0000u);
                    const float y2 = O[sb][dt][4 * g4 + 2] * il * __uint_as_float(z.y << 16), y3 = O[sb][dt][4 * g4 + 3] * il * __uint_as_float(z.y & 0xffff0000u);
                    u32x2 w; w.x = pg8::cvt_pk_bf16(y0, y1); w.y = pg8::cvt_pk_bf16(y2, y3); *(u32x2*)(YB + off) = w; } }
    }
}

__device__ __forceinline__ float gelu_fast(float x) { const float u = x * (1.5957691216057308f + 0.07135481627159768f * x * x); return x * __builtin_amdgcn_rcpf(1.f + __builtin_amdgcn_exp2f(-1.4426950408889634f * u)); }
struct EpiGmlpIn {
    static constexpr bool PERM = true;
    unsigned char* ws;
    __device__ __forceinline__ void operator()(const pg8::f32x4 (&acc)[2][2][4][2], const Unit& u, int wr, int wc, int fr, int fq) const {
        { int t_ = tidx(); fr = t_ & 15; fq = (t_ >> 4) & 3; }
        const int kind = u.pn >> 4; bf16* const O = (bf16*)(ws + (kind == 0 ? WS_UG : (kind == 1 ? WS_VG : WS_ZG))); const int cb = (u.pn & 15) * 256 + wc * 32 + 8 * fq;
#pragma unroll
        for (int ai = 0; ai < 2; ++ai)
#pragma unroll
            for (int m = 0; m < 4; ++m) { if (ai >= u.na) break; const int row = u.pm * 256 + u.roff + ai * 128 + wr * 64 + m * 16 + fr; float s1 = 0.f, s2 = 0.f;
#pragma unroll
                for (int bj = 0; bj < 2; ++bj) { pg8::f32x4 a = acc[ai][bj][m][0], b = acc[ai][bj][m][1];
                    if (kind == 2) {
#pragma unroll
                        for (int e = 0; e < 4; ++e) { a[e] = silu_f(a[e]); b[e] = silu_f(b[e]); } }
                    else {
#pragma unroll
                        for (int e = 0; e < 4; ++e) { a[e] = gelu_fast(a[e]); b[e] = gelu_fast(b[e]); s1 += a[e] + b[e]; s2 += a[e] * a[e] + b[e] * b[e]; } }
                    *(u32x4*)(O + (size_t)row * 4096 + cb + bj * 128) = pack8(a, b); }
                if (kind == 1) { s1 += __shfl_xor(s1, 16); s1 += __shfl_xor(s1, 32); s2 += __shfl_xor(s2, 16); s2 += __shfl_xor(s2, 32);
                    if (fq == 0) { float* st = (float*)(ws + WS_STAT) + ((size_t)row * 64 + (u.pn - 16) * 4 + wc) * 2; st[0] = s1; st[1] = s2; } } }
    }
};
__device__ __forceinline__ void phase_inproj_gmlp(const Params& p, unsigned char* lds) {
    pg8::Gemm g{DM, DM, DM};
    SchedLin S; S.init(MT, 12288, gridDim.x, blockIdx.x, true); S.plain(p.ws + WS_HB, DM, p.ws + WS_WIN, DM);
    EpiGmlpIn E{p.ws};
    pg8::gemm_phase<EpiGmlpIn, SchedLin>((PG8_LAS unsigned char*)lds, g, S, E);
}
template <int NTOK> __device__ __forceinline__ void gmlp_ln_item(const Params& p, unsigned char* lds, int chunk, int toff) {
    const int tid = tidx();
    float* mr = (float*)lds;
    bf16* T = (bf16*)(lds + 1024);
    const bf16* VG = (const bf16*)(p.ws + WS_VG); bf16* VT2 = (bf16*)(p.ws + WS_VT2); const float* STAT = (const float*)(p.ws + WS_STAT);
    const float* lg = p.in[15]; const float* lb = p.in[16];
    const int row0 = chunk * 128 + toff;
    __syncthreads();
    { const int t = tid >> 3, q = tid & 7;
      if (t < NTOK) { const float* st = STAT + ((size_t)(row0 + t) * 64 + q * 8) * 2; float s1 = 0.f, s2 = 0.f;
#pragma unroll
          for (int e = 0; e < 8; ++e) { s1 += st[2 * e]; s2 += st[2 * e + 1]; }
          s1 += __shfl_xor(s1, 1); s1 += __shfl_xor(s1, 2); s1 += __shfl_xor(s1, 4); s2 += __shfl_xor(s2, 1); s2 += __shfl_xor(s2, 2); s2 += __shfl_xor(s2, 4);
          if (q == 0) { const float mu = s1 * (1.f / 4096.f); const float var = fmaxf(s2 * (1.f / 4096.f) - mu * mu, 0.f); mr[2 * t] = mu; mr[2 * t + 1] = rsqrtf(var + EPS); } } }
    __syncthreads();
    u32x4 wv[NTOK / 16], wn[NTOK / 16];
#pragma unroll
    for (int i = 0; i < NTOK / 16; ++i) { const int pc = tid + i * NTHR, t = pc >> 5, c8 = (pc & 31) * 8; wv[i] = *(const u32x4*)(VG + (size_t)(row0 + t) * 4096 + c8); }
    for (int g = 0; g < 16; ++g) {
        if (g < 15) {
#pragma unroll
            for (int i = 0; i < NTOK / 16; ++i) { const int pc = tid + i * NTHR, t = pc >> 5, c8 = (pc & 31) * 8; wn[i] = *(const u32x4*)(VG + (size_t)(row0 + t) * 4096 + (g + 1) * 256 + c8); } }
#pragma unroll
        for (int i = 0; i < NTOK / 16; ++i) { const int pc = tid + i * NTHR, t = pc >> 5, c8 = (pc & 31) * 8; const u32x4 w = wv[i];
            const float mu = mr[2 * t], rs = mr[2 * t + 1]; const f32x4 g0 = *(const f32x4*)(lg + g * 256 + c8), g1 = *(const f32x4*)(lg + g * 256 + c8 + 4), b0 = *(const f32x4*)(lb + g * 256 + c8), b1 = *(const f32x4*)(lb + g * 256 + c8 + 4);
            u32x4 o; o.x = pk2((__uint_as_float(w.x << 16) - mu) * rs * g0.x + b0.x, (__uint_as_float(w.x & 0xffff0000u) - mu) * rs * g0.y + b0.y);
            o.y = pk2((__uint_as_float(w.y << 16) - mu) * rs * g0.z + b0.z, (__uint_as_float(w.y & 0xffff0000u) - mu) * rs * g0.w + b0.w);
            o.z = pk2((__uint_as_float(w.z << 16) - mu) * rs * g1.x + b1.x, (__uint_as_float(w.z & 0xffff0000u) - mu) * rs * g1.y + b1.y);
            o.w = pk2((__uint_as_float(w.w << 16) - mu) * rs * g1.z + b1.z, (__uint_as_float(w.w & 0xffff0000u) - mu) * rs * g1.w + b1.w);
            *(u32x4*)(T + t * 264 + c8) = o; }
        __syncthreads();
        { const int c = tid >> 1, t0 = (tid & 1) * (NTOK / 2); bf16* dst = VT2 + ((size_t)(chunk * 4096 + g * 256 + c) * 128 + toff + t0);
#pragma unroll
          for (int q = 0; q < NTOK / 16; ++q) { u32x4 o; const bf16* sp = T + (t0 + 8 * q) * 264 + c;
              o.x = (unsigned)sp[0] | ((unsigned)sp[264] << 16); o.y = (unsigned)sp[2 * 264] | ((unsigned)sp[3 * 264] << 16); o.z = (unsigned)sp[4 * 264] | ((unsigned)sp[5 * 264] << 16); o.w = (unsigned)sp[6 * 264] | ((unsigned)sp[7 * 264] << 16);
              *(u32x4*)(dst + 8 * q) = o; } }
        __syncthreads();
#pragma unroll
        for (int i = 0; i < NTOK / 16; ++i) wv[i] = wn[i];
    }
}
__device__ __forceinline__ void phase_gmlp_ln(const Params& p, unsigned char* lds) {
    for (int item = blockIdx.x; item < 256 + 32; item += gridDim.x) {
        if (item < 256) gmlp_ln_item<64>(p, lds, item >> 1, (item & 1) * 64);
        else { const int i2 = item - 256; gmlp_ln_item<16>(p, lds, 128 + (i2 >> 3), (i2 & 7) * 16); }
    }
}
struct EpiGmlpS {
    static constexpr bool PERM = true;
    unsigned char* ws; const float* bs;
    __device__ __forceinline__ void operator()(const pg8::f32x4 (&acc)[2][2][4][2], const Unit& u, int wr, int wc, int fr, int fq) const {
        { int t_ = tidx(); fr = t_ & 15; fq = (t_ >> 4) & 3; }
        bf16* const UG = (bf16*)(ws + WS_UG); const bf16* const ZG = (const bf16*)(ws + WS_ZG);
        u32x4 uv[4][2], zv[4][2]; float bias[4];
#pragma unroll
        for (int m = 0; m < 4; ++m) { const int sl = wr * 64 + m * 16 + fr; bias[m] = bs[u.pn * 128 + sl];
#pragma unroll
            for (int bj = 0; bj < 2; ++bj) { const size_t off = (size_t)(u.pm * 128 + sl) * 4096 + u.pn * 256 + bj * 128 + wc * 32 + 8 * fq; uv[m][bj] = *(const u32x4*)(UG + off); zv[m][bj] = *(const u32x4*)(ZG + off); } }
#pragma unroll
        for (int m = 0; m < 4; ++m) { const int sl = wr * 64 + m * 16 + fr;
#pragma unroll
            for (int bj = 0; bj < 2; ++bj) { const size_t off = (size_t)(u.pm * 128 + sl) * 4096 + u.pn * 256 + bj * 128 + wc * 32 + 8 * fq;
                const u32x4 uu = uv[m][bj], zz = zv[m][bj]; pg8::f32x4 a = acc[0][bj][m][0] + bias[m], b = acc[0][bj][m][1] + bias[m];
                a[0] *= __uint_as_float(uu.x << 16) * __uint_as_float(zz.x << 16); a[1] *= __uint_as_float(uu.x & 0xffff0000u) * __uint_as_float(zz.x & 0xffff0000u);
                a[2] *= __uint_as_float(uu.y << 16) * __uint_as_float(zz.y << 16); a[3] *= __uint_as_float(uu.y & 0xffff0000u) * __uint_as_float(zz.y & 0xffff0000u);
                b[0] *= __uint_as_float(uu.z << 16) * __uint_as_float(zz.z << 16); b[1] *= __uint_as_float(uu.z & 0xffff0000u) * __uint_as_float(zz.z & 0xffff0000u);
                b[2] *= __uint_as_float(uu.w << 16) * __uint_as_float(zz.w << 16); b[3] *= __uint_as_float(uu.w & 0xffff0000u) * __uint_as_float(zz.w & 0xffff0000u);
                *(u32x4*)(UG + off) = pack8(a, b); } }
    }
};
__device__ __forceinline__ void phase_gmlp_spatial(const Params& p, unsigned char* lds) {
    pg8::Gemm g{128, 128, 128};
    SchedLin S; S.init(132 * 256, 4096, gridDim.x, blockIdx.x); S.A0 = (const char*)(p.ws + WS_WSB); S.sAm = 0; S.sAn = 128 * 128 * 2; S.B0 = (const char*)(p.ws + WS_VT2); S.sBm = (size_t)4096 * 128 * 2; S.sBn = 256 * 128 * 2;
    EpiGmlpS E{p.ws, p.in[14]};
    pg8::gemm_phase<EpiGmlpS, SchedLin, true>((PG8_LAS unsigned char*)lds, g, S, E);
}

__device__ __forceinline__ void phase_final(const Params& p) {
    const int lane = tidx() & 63, gw = blockIdx.x * NWAVES + (tidx() >> 6), NGW = gridDim.x * NWAVES;
    const float* gvec = p.in[17];
    f32x4 x[8], xn[8];
    int row = gw;
    if (row < ML) {
#pragma unroll
        for (int j = 0; j < 8; ++j) x[j] = *(const f32x4*)(p.out + (size_t)row * DM + 4 * lane + 256 * j); }
    for (; row < ML; row += NGW) {
        const int rn = row + NGW;
        if (rn < ML) {
#pragma unroll
            for (int j = 0; j < 8; ++j) xn[j] = *(const f32x4*)(p.out + (size_t)rn * DM + 4 * lane + 256 * j); }
        float* xr = p.out + (size_t)row * DM; float s = 0.f;
#pragma unroll
        for (int j = 0; j < 8; ++j) s += (x[j].x * x[j].x + x[j].y * x[j].y) + (x[j].z * x[j].z + x[j].w * x[j].w);
        const float rstd = rsqrtf(wave_sum(s) * (1.f / DM) + EPS);
#pragma unroll
        for (int j = 0; j < 8; ++j) { const int c0 = 4 * lane + 256 * j; const f32x4 g4 = *(const f32x4*)(gvec + c0); *(f32x4*)(xr + c0) = x[j] * rstd * g4; }
#pragma unroll
        for (int j = 0; j < 8; ++j) x[j] = xn[j];
    }
}

#define XB_TMO      128
#define XB_XCNT(j)  (256  + 64 * (j))
#define XB_XSUB(j)  (1280 + 64 * (j))
#define XB_XGEN(j)  (2304 + 64 * (j))
#define XB_TOP      3328
#define XB_TOPGEN   3392
#define XCD_BAR_WORDS 3456
#define XB_SPIN_CAP (1u << 22)
__device__ __forceinline__ unsigned xb_ld(unsigned* p)              { return __hip_atomic_load(p, __ATOMIC_RELAXED, __HIP_MEMORY_SCOPE_AGENT); }
__device__ __forceinline__ unsigned xb_add(unsigned* p, unsigned v) { return __hip_atomic_fetch_add(p, v, __ATOMIC_RELAXED, __HIP_MEMORY_SCOPE_AGENT); }
__device__ __forceinline__ unsigned xb_xcc_id() { return (unsigned)__builtin_amdgcn_s_getreg((3 << 11) | 20) & 0xFu; }
#define XB_SPIN(cond, bar) do { unsigned _sp = 0; while (cond) { \
    if ((++_sp & 255u) == 0u) { if (xb_ld(&(bar)[XB_TMO])) break; if (_sp > XB_SPIN_CAP) { atomicAdd(&(bar)[XB_TMO], 1u); break; } } } } while (0)
struct XcdBarrier { unsigned* bar; unsigned x; volatile __attribute__((address_space(3))) unsigned* st; };
__device__ __forceinline__ XcdBarrier xcd_barrier_post(unsigned* bar, volatile __attribute__((address_space(3))) unsigned* st) {
    XcdBarrier b; b.bar = bar; b.x = xb_xcc_id(); b.st = st;
    if (threadIdx.x == 0) (void)xb_add(&bar[XB_XCNT(b.x)], 1u);
    return b;
}
__device__ __forceinline__ void xcd_barrier_complete(unsigned* bar, unsigned x, unsigned& nloc, unsigned& nx) {
    const unsigned G = gridDim.x * gridDim.y * gridDim.z;
    unsigned sum, cnt, mine, sp = 0u;
    for (;;) {
        sum = 0u; cnt = 0u; mine = 0u;
#pragma unroll
        for (unsigned j = 0; j < 16; ++j) { const unsigned c = xb_ld(&bar[XB_XCNT(j)]); sum += c; cnt += (c > 0u) ? 1u : 0u; mine = (j == x) ? c : mine; }
        if (sum == G) break;
        __builtin_amdgcn_s_sleep(1);
        if ((++sp & 255u) == 0u) { if (xb_ld(&bar[XB_TMO])) break; if (sp > XB_SPIN_CAP) { atomicAdd(&bar[XB_TMO], 1u); break; } }
    }
    nloc = mine > 0u ? mine : 1u; nx = cnt > 0u ? cnt : 1u;
}
__device__ __forceinline__ void xcd_barrier(const XcdBarrier& b) {
    asm volatile("s_waitcnt vmcnt(0)" ::: "memory");
    __syncthreads();
    if (threadIdx.x == 0) {
        unsigned* bar = b.bar;
        __builtin_amdgcn_s_waitcnt(0);
        unsigned nloc = b.st[0], nx = b.st[1];
        if (nloc == 0u) { xcd_barrier_complete(bar, b.x, nloc, nx); b.st[0] = nloc; b.st[1] = nx; }
        const unsigned old = xb_add(&bar[XB_XSUB(b.x)], 1u);
        const unsigned gen = old / nloc;
        if (old + 1u == (gen + 1u) * nloc) {
            __builtin_amdgcn_fence(__ATOMIC_RELEASE, "agent");
            asm volatile("s_waitcnt vmcnt(0)" ::: "memory");
            const unsigned og = xb_add(&bar[XB_TOP], 1u);
            const unsigned tg = og / nx;
            if (og + 1u == (tg + 1u) * nx) xb_add(&bar[XB_TOPGEN], 1u);
            else XB_SPIN(xb_ld(&bar[XB_TOPGEN]) == tg, bar);
            __builtin_amdgcn_fence(__ATOMIC_ACQUIRE, "agent");
            xb_add(&bar[XB_XGEN(b.x)], 1u);
            asm volatile("s_waitcnt vmcnt(0)" ::: "memory");
        } else {
            XB_SPIN(xb_ld(&bar[XB_XGEN(b.x)]) == gen, bar);
            __builtin_amdgcn_fence(__ATOMIC_ACQUIRE, "agent");
            asm volatile("s_waitcnt vmcnt(0)" ::: "memory");
        }
    }
    __syncthreads();
}

constexpr int NPH = 23;
__global__ void __launch_bounds__(NTHR, 2) fwd(Params p) {
    extern __shared__ __attribute__((aligned(16))) unsigned char lds[];
    cg::grid_group grid = cg::this_grid();
    const int lo = p.ph_lo, hi = p.ph_hi;
    volatile __attribute__((address_space(3))) unsigned* bst = (volatile __attribute__((address_space(3))) unsigned*)((__attribute__((address_space(3))) unsigned char*)lds + 131072 + 2048);
    if (threadIdx.x < 2) bst[threadIdx.x] = 0u;
    __syncthreads();
    const XcdBarrier xbar = xcd_barrier_post((unsigned*)(p.ws + WS_BAR), bst);
    if (hi > 1000) grid.sync();
#define PHASE(k, ...) if (lo <= (k) && (k) < hi) { __VA_ARGS__; if ((k) + 1 < hi) xcd_barrier(xbar); }
    PHASE(0, phase0(p, lds))
    PHASE(1, phase_prep<0>(p, lds))
    PHASE(2, phase_inproj_fnet<0>(p, lds))
    PHASE(3, phase_fnet_a(p, true, lds))
    PHASE(4, phase_fnet_c(p, lds))
    PHASE(5, phase_fnet_mix<0>(p, lds))
    PHASE(6, phase_outproj<0>(p, lds))
    PHASE(7, phase_prep<1>(p, lds))
    PHASE(8, phase_inproj_attn(p, lds))
    PHASE(9, phase_attn(p, lds))
    PHASE(10, phase_outproj<1>(p, lds))
    PHASE(11, phase_prep<2>(p, lds))
    PHASE(12, phase_inproj_gmlp(p, lds))
    PHASE(13, phase_gmlp_ln(p, lds))
    PHASE(14, phase_gmlp_spatial(p, lds))
    PHASE(15, phase_outproj<2>(p, lds))
    PHASE(16, phase_prep<3>(p, lds))
    PHASE(17, phase_inproj_fnet<3>(p, lds))
    PHASE(18, phase_fnet_a(p, false, lds))
    PHASE(19, phase_fnet_c(p, lds))
    PHASE(20, phase_fnet_mix<3>(p, lds))
    PHASE(21, phase_outproj<3>(p, lds))
    PHASE(22, phase_final(p))
#undef PHASE
}

extern "C" void kernel_launch(void* const* d_in, const int* in_sizes, int n_in, void* d_out, int out_size, void* d_ws, size_t ws_size, hipStream_t stream) {
    static int grid = 0;
    if (grid == 0) {
        int dev = 0, cus = 0, per_cu = 0;
        (void)hipGetDevice(&dev); (void)hipDeviceGetAttribute(&cus, hipDeviceAttributeMultiprocessorCount, dev);
        (void)hipFuncSetAttribute((const void*)fwd, hipFuncAttributeMaxDynamicSharedMemorySize, LDS_BYTES);
        (void)hipOccupancyMaxActiveBlocksPerMultiprocessor(&per_cu, (const void*)fwd, NTHR, LDS_BYTES);
        if (per_cu < 1) { fprintf(stderr, "kernel_launch: occupancy query says %d blocks per CU\n", per_cu); per_cu = 1; }
        (void)hipGetLastError();
        grid = cus;
        if (n_in != 18 || ws_size < WS_END) fprintf(stderr, "kernel_launch: unexpected n_in %d / ws_size %zu\n", n_in, ws_size);
    }
    (void)hipMemsetAsync((char*)d_ws + WS_BAR, 0, XCD_BAR_WORDS * 4, stream);
    Params p{};
    for (int i = 0; i < 18; ++i) p.in[i] = (const float*)d_in[i];
    p.out = (float*)d_out; p.ws = (unsigned char*)d_ws;
#if MK_COOP
    p.ph_lo = 0; p.ph_hi = NPH;
    void* args[] = {&p};
    hipError_t e = hipLaunchCooperativeKernel((const void*)fwd, dim3(grid), dim3(NTHR), args, LDS_BYTES, stream);
    if (e != hipSuccess) fprintf(stderr, "cooperative launch failed: %s (grid %d)\n", hipGetErrorString(e), grid);
#else
    for (int ph = 0; ph < NPH; ++ph) { p.ph_lo = ph; p.ph_hi = ph + 1; hipLaunchKernelGGL(fwd, dim3(grid), dim3(NTHR), LDS_BYTES, stream, p); }
#endif
}
```

```cpp
#include <hip/hip_runtime.h>
#include <hip/hip_cooperative_groups.h>
#include <cstdio>
#include <cstdint>
namespace cg = cooperative_groups;

#ifndef MK_COOP
#define MK_COOP 1
#endif

__device__ __forceinline__ int tidx() { int t = threadIdx.x; asm volatile("" : "+v"(t)); return t; }
namespace pg8 {
#define PG8_LAS __attribute__((address_space(3)))
typedef unsigned short bf16_t;
typedef short bf16x8 __attribute__((ext_vector_type(8)));
typedef float f32x4 __attribute__((ext_vector_type(4)));
typedef unsigned u32x4 __attribute__((ext_vector_type(4)));
constexpr int BM = 256, BK = 64, HALF = 128, HTB = HALF * BK * 2, STAGE_BYTES = 8 * HTB, NXCD = 8, WGM = 8;

__host__ __device__ __forceinline__ int lds_byte(int r, int c) { const int st = (r >> 4) * 2 + (c >> 5), rr = r & 15, cc = c & 31, ob = rr * 64 + cc * 2; return st * 1024 + (ob ^ (((ob >> 9) & 1) << 5)); }
__host__ __device__ __forceinline__ void stage_rc(int b, int& R, int& C) { const int st = b / 1024, sb = b % 1024, swz = sb ^ (((sb >> 9) & 1) << 5); R = (st >> 1) * 16 + swz / 64; C = (st & 1) * 32 + (swz % 64) / 2; }
__host__ __device__ __forceinline__ int perm32(int rho) { const int n = rho >> 4, i = rho & 15; return 8 * (i >> 2) + 4 * n + (i & 3); }

struct Unit { int pm, pn, na, roff; };
struct Gemm { int lda, ldb, K; };

struct StaticOrder {
    int nM, nN, nwg, G, c, nfull;
    __host__ __device__ void init(int M, int N, int G_, int c_, bool split = false) { nM = M / BM; nN = N / BM; nwg = nM * nN; G = G_; c = c_; nfull = nwg;
        if (split) { const int nf = (nwg / G) * G; if (2 * (nwg - nf) <= G) nfull = nf; } }
    __host__ __device__ void map(int wgid, Unit& u) const {
        { const int q = nwg / NXCD, r = nwg % NXCD, xcd = wgid % NXCD, off = wgid / NXCD; wgid = (xcd < r ? xcd * (q + 1) : r * (q + 1) + (xcd - r) * q) + off; }
        const int nig = WGM * nN, gid = wgid / nig, fm = gid * WGM, gsz = (nM - fm) < WGM ? (nM - fm) : WGM;
        u.pm = fm + ((wgid % nig) % gsz); u.pn = (wgid % nig) / gsz; }
    __host__ __device__ bool next(int i, Unit& u) const {
        const long L = (long)i * G + c;
        if (L < nfull) { map((int)L, u); u.na = 2; u.roff = 0; return true; }
        const long h = L - nfull; if (h >= 2L * (nwg - nfull)) return false;
        map(nfull + (int)(h >> 1), u); u.na = 1; u.roff = (int)(h & 1) * HALF; return true;
    }
};

__device__ __forceinline__ unsigned cvt_pk_bf16(float lo, float hi) { unsigned r; asm volatile("v_cvt_pk_bf16_f32 %0, %1, %2" : "=v"(r) : "v"(lo), "v"(hi)); return r; }

struct EpiResid {
    static constexpr bool PERM = false;
    const float* rl; float* xl; const float* gate;
    __device__ __forceinline__ void operator()(const f32x4 (&acc)[2][2][4][2], const Unit& u, int wr, int wc, int fr, int fq) const {
        { int t_ = tidx(); fr = t_ & 15; fq = (t_ >> 4) & 3; }
        const int col0 = u.pn * BM + wc * 32 + 4 * fq; const float* gp = gate + ((u.pm * BM) >> 13) * 6144 + 4096 + col0;
        f32x4 g4[2][2];
#pragma unroll
        for (int bj = 0; bj < 2; ++bj)
#pragma unroll
            for (int n = 0; n < 2; ++n) g4[bj][n] = *(const f32x4*)(gp + bj * HALF + n * 16);
#pragma unroll
        for (int ai = 0; ai < 2; ++ai) {
            f32x4 xv[4][2][2];
#pragma unroll
            for (int m = 0; m < 4; ++m) { const float* rr = rl + (size_t)(u.pm * BM + ai * HALF + wr * 64 + m * 16 + fr) * 2048 + col0;
#pragma unroll
                for (int bj = 0; bj < 2; ++bj)
#pragma unroll
                    for (int n = 0; n < 2; ++n) xv[m][bj][n] = *(const f32x4*)(rr + bj * HALF + n * 16); }
#pragma unroll
            for (int m = 0; m < 4; ++m) { float* xr = xl + (size_t)(u.pm * BM + ai * HALF + wr * 64 + m * 16 + fr) * 2048 + col0;
#pragma unroll
                for (int bj = 0; bj < 2; ++bj)
#pragma unroll
                    for (int n = 0; n < 2; ++n) *(f32x4*)(xr + bj * HALF + n * 16) = xv[m][bj][n] + g4[bj][n] * acc[ai][bj][m][n]; }
            asm volatile("" ::: "memory");
        }
    }
};

__device__ __forceinline__ const char* uni(const char* p) { const unsigned long long v = (unsigned long long)p; const unsigned lo = __builtin_amdgcn_readfirstlane((unsigned)v), hi = __builtin_amdgcn_readfirstlane((unsigned)(v >> 32)); return (const char*)(((unsigned long long)hi << 32) | lo); }
struct EpiPart {
    static constexpr bool PERM = false;
    float* part;
    __device__ __forceinline__ void operator()(const f32x4 (&acc)[2][2][4][2], const Unit& u, int wr, int wc, int fr, int fq) const {
        { int t_ = tidx(); fr = t_ & 15; fq = (t_ >> 4) & 3; }
        const int ks = u.pn >> 3, col0 = (u.pn & 7) * BM + wc * 32 + 4 * fq;
#pragma unroll
        for (int ai = 0; ai < 2; ++ai)
#pragma unroll
            for (int m = 0; m < 4; ++m) { float* o = part + ((size_t)(ks * 512 + u.pm * BM + ai * HALF + wr * 64 + m * 16 + fr)) * 2048 + col0;
#pragma unroll
                for (int bj = 0; bj < 2; ++bj)
#pragma unroll
                    for (int n = 0; n < 2; ++n) *(f32x4*)(o + bj * HALF + n * 16) = acc[ai][bj][m][n]; }
    }
};
template <class Epi, class Sched, bool HALFM = false>
__device__ __forceinline__ void gemm_phase(PG8_LAS unsigned char* lds, const Gemm g, const Sched& S, const Epi& E) {
    int tid_ = tidx();
    const int tid = tid_, wid = __builtin_amdgcn_readfirstlane(tid >> 6), lane = tid & 63, wr = wid >> 2, wc = wid & 3, fr = lane & 15, fq = lane >> 4;
    int K_ = g.K; asm volatile("" : "+s"(K_));
    const int K = K_, nt = K / BK;
    unsigned voffA[2], voffB[2];
#pragma unroll
    for (int i = 0; i < 2; ++i) { int R, C; stage_rc(tid * 16 + i * 8192, R, C); const int Rb = Epi::PERM ? ((R & ~31) + perm32(R & 31)) : R;
        voffA[i] = (unsigned)(R * g.lda + C) * 2u; voffB[i] = (unsigned)(Rb * g.ldb + C) * 2u; }
    const size_t kstep = (size_t)(BK * 2);
    const size_t hstepA = (size_t)HALF * g.lda * 2, hstepB = (size_t)HALF * g.ldb * 2;
    const unsigned ldsw = (unsigned)wid * 1024u;
    const int aoff = lds_byte(wr * 64 + fr, fq * 8), boff = lds_byte(wc * 32 + fr, fq * 8);
#define PG8_SA(b, h) (((b) * 2 + (h)) * HTB)
#define PG8_SB(b, h) ((4 + (b) * 2 + (h)) * HTB)
#define PG8_STAGE(bufoff, gbase, voff) do { _Pragma("unroll") for (int _i = 0; _i < 2; ++_i) \
        __builtin_amdgcn_global_load_lds((const unsigned*)((const char*)(gbase) + (voff)[_i]), (PG8_LAS unsigned*)(lds + (bufoff) + ldsw + _i * 8192), 16, 0, 0); } while (0)
#define PG8_LDA(dst, b, h) do { _Pragma("unroll") for (int m = 0; m < 4; ++m) _Pragma("unroll") for (int k = 0; k < 2; ++k) dst[m][k] = *(const PG8_LAS bf16x8*)(lds + PG8_SA(b, h) + aoff + m * 2048 + k * 1024); } while (0)
#define PG8_LDB(dst, b, h) do { _Pragma("unroll") for (int n = 0; n < 2; ++n) _Pragma("unroll") for (int k = 0; k < 2; ++k) dst[n][k] = *(const PG8_LAS bf16x8*)(lds + PG8_SB(b, h) + boff + n * 2048 + k * 1024); } while (0)
#define PG8_MMA(ai, bj, At, Bt) do { __builtin_amdgcn_s_setprio(1); _Pragma("unroll") for (int m = 0; m < 4; ++m) _Pragma("unroll") for (int n = 0; n < 2; ++n) _Pragma("unroll") for (int k = 0; k < 2; ++k) \
        acc[ai][bj][m][n] = __builtin_amdgcn_mfma_f32_16x16x32_bf16(Bt[n][k], At[m][k], acc[ai][bj][m][n], 0, 0, 0); __builtin_amdgcn_s_setprio(0); } while (0)
#define PG8_WAIT_V(n) asm volatile("s_waitcnt vmcnt(" #n ")" ::: "memory")
#define PG8_WAIT_L(n) asm volatile("s_waitcnt lgkmcnt(" #n ")" ::: "memory")
#define PG8_BAR __builtin_amdgcn_s_barrier()
#define PG8_SCHED __builtin_amdgcn_sched_barrier(0)
    Unit cur, nxt; int ui = 0;
    if (!S.next(0, cur)) return;
    f32x4 acc[2][2][4][2];
#pragma unroll
    for (int a = 0; a < 2; ++a)
#pragma unroll
        for (int b = 0; b < 2; ++b)
#pragma unroll
            for (int m = 0; m < 4; ++m)
#pragma unroll
                for (int n = 0; n < 2; ++n) acc[a][b][m][n] = (f32x4){0.f, 0.f, 0.f, 0.f};
    bf16x8 At[4][2], B0[2][2], B1[2][2];
    const char* cA = uni(S.aptr(cur)); const char* cB = uni(S.bptr(cur));
    {
        PG8_STAGE(PG8_SB(0, 0), cB, voffB); PG8_STAGE(PG8_SB(0, 1), cB + hstepB, voffB); PG8_STAGE(PG8_SA(0, 0), cA, voffA); PG8_STAGE(PG8_SA(0, 1), cA + hstepA, voffA);
        if (wr == 1) PG8_BAR;
        PG8_WAIT_V(2); PG8_BAR;
        PG8_STAGE(PG8_SB(1, 0), cB + kstep, voffB); PG8_STAGE(PG8_SA(1, 0), cA + kstep, voffA); PG8_STAGE(PG8_SB(1, 1), cB + hstepB + kstep, voffB);
        PG8_WAIT_V(6); PG8_BAR;
    }
    for (;;) {
        const bool has_next = S.next(ui + 1, nxt);
        const char* nA = has_next ? uni(S.aptr(nxt)) : cA; const char* nB = has_next ? uni(S.bptr(nxt)) : cB;
        for (int t = 0; t < nt; t += 2) {
            const bool last = (t == nt - 2);
            const char* a1 = cA + (size_t)(t + 1) * kstep;
            const char* a2 = last ? nA : cA + (size_t)(t + 2) * kstep; const char* b2 = last ? nB : cB + (size_t)(t + 2) * kstep;
            const char* a3 = a2 + kstep; const char* b3 = b2 + kstep;
            PG8_LDB(B0, 0, 0); PG8_LDB(B1, 0, 1); PG8_SCHED; PG8_LDA(At, 0, 0); PG8_STAGE(PG8_SA(1, 1), a1 + hstepA, voffA);
            PG8_WAIT_V(8); PG8_WAIT_L(0); PG8_BAR; PG8_MMA(0, 0, At, B0); PG8_MMA(0, 1, At, B1); PG8_BAR; PG8_SCHED;
            PG8_LDA(At, 0, 1); PG8_STAGE(PG8_SB(0, 0), b2, voffB); PG8_STAGE(PG8_SB(0, 1), b2 + hstepB, voffB); PG8_STAGE(PG8_SA(0, 0), a2, voffA);
            PG8_WAIT_V(8); PG8_WAIT_L(0); PG8_BAR; if (HALFM ? false : cur.na == 2) { PG8_MMA(1, 0, At, B0); PG8_MMA(1, 1, At, B1); } PG8_BAR; PG8_SCHED;
            PG8_LDB(B0, 1, 0); PG8_LDB(B1, 1, 1); PG8_SCHED; PG8_LDA(At, 1, 0); PG8_STAGE(PG8_SA(0, 1), a2 + hstepA, voffA);
            PG8_WAIT_V(8); PG8_WAIT_L(0); PG8_BAR; PG8_MMA(0, 0, At, B0); PG8_MMA(0, 1, At, B1); PG8_BAR; PG8_SCHED;
            PG8_LDA(At, 1, 1); PG8_STAGE(PG8_SB(1, 0), b3, voffB); PG8_STAGE(PG8_SB(1, 1), b3 + hstepB, voffB); PG8_STAGE(PG8_SA(1, 0), a3, voffA);
            PG8_WAIT_V(8); PG8_WAIT_L(0); PG8_BAR; if (HALFM ? false : cur.na == 2) { PG8_MMA(1, 0, At, B0); PG8_MMA(1, 1, At, B1); } PG8_BAR; PG8_SCHED;
        }
        if (wr == 0) PG8_BAR;
        E(acc, cur, wr, wc, fr, fq);
        if (!has_next) break;
#pragma unroll
        for (int a = 0; a < 2; ++a)
#pragma unroll
            for (int b = 0; b < 2; ++b)
#pragma unroll
                for (int m = 0; m < 4; ++m)
#pragma unroll
                    for (int n = 0; n < 2; ++n) acc[a][b][m][n] = (f32x4){0.f, 0.f, 0.f, 0.f};
        cur = nxt; cA = nA; cB = nB; ++ui;
        if (wr == 1) PG8_BAR;
    }
    PG8_WAIT_V(0);
    PG8_BAR;
#undef PG8_SA
#undef PG8_SB
#undef PG8_STAGE
#undef PG8_LDA
#undef PG8_LDB
#undef PG8_MMA
#undef PG8_WAIT_V
#undef PG8_WAIT_L
#undef PG8_BAR
#undef PG8_SCHED
}
}

typedef unsigned short bf16;
typedef float f32x4 __attribute__((ext_vector_type(4)));
typedef unsigned u32x4 __attribute__((ext_vector_type(4)));
typedef unsigned u32x2 __attribute__((ext_vector_type(2)));
constexpr int DM = 2048, SEQ = 8192, ML = 16384, MC = 512, MT = ML + MC, DBR = 4096, CTXL = 256, DEPTH = 4;
constexpr int NTHR = 512, NWAVES = 8;
constexpr float EPS = 1e-6f;
constexpr size_t MiB = 1u << 20;
constexpr size_t WS_MOD = 0;
constexpr size_t WS_BAR = 512 * 1024;
constexpr size_t WS_XC = 1 * MiB;
constexpr size_t WS_TAB = 5 * MiB;
constexpr size_t TAB_ROPE = WS_TAB + 65536, TAB_DA = WS_TAB + 131072, TAB_CASPM = WS_TAB + 262144;
constexpr size_t WS_WIN = 8 * MiB;
constexpr size_t WS_WOUT = 56 * MiB;
constexpr size_t WS_BMIX = 72 * MiB;
constexpr size_t WS_HB = 76 * MiB;
constexpr size_t WS_PB = 142 * MiB;
constexpr size_t WS_YB = 538 * MiB;
constexpr size_t WS_QB = 142 * MiB;
constexpr size_t WS_KB = 274 * MiB;
constexpr size_t WS_VT = 291 * MiB;
constexpr size_t WS_VTC = 307 * MiB;
constexpr size_t WS_ZA = 308 * MiB;
constexpr size_t WS_UG = 142 * MiB;
constexpr size_t WS_VG = 274 * MiB;
constexpr size_t WS_ZG = 406 * MiB;
constexpr size_t WS_VT2 = 538 * MiB;
constexpr size_t WS_STAT = 670 * MiB;
constexpr size_t WS_WSB = 72 * MiB;
constexpr size_t WS_TO = 76 * MiB;
constexpr size_t WS_U1 = 142 * MiB;
constexpr size_t WS_UCT = 270 * MiB;
constexpr size_t WS_ZB = 340 * MiB;
constexpr size_t WS_YP = 472 * MiB;
constexpr size_t WS_YB_F = 472 * MiB;
constexpr size_t TAB_DC2 = 760 * MiB;
constexpr size_t WS_PART = 728 * MiB;
constexpr size_t WS_END = 768 * MiB;
static_assert(WS_YP + (size_t)256 * MiB <= WS_END && WS_YB + (size_t)MT * DBR * 2 <= WS_END, "ws map");
constexpr int LDS_BYTES = 135168;

struct Params { const float* in[18]; float* out; unsigned char* ws; int ph_lo, ph_hi; };

__device__ __forceinline__ float bf2f(bf16 h) { return __uint_as_float((unsigned)h << 16); }
__device__ __forceinline__ unsigned f2bf(float f) { unsigned u = __float_as_uint(f); return (u + 0x7fffu + ((u >> 16) & 1u)) >> 16; }
__device__ __forceinline__ unsigned pk2(float lo, float hi) { return f2bf(lo) | (f2bf(hi) << 16); }
__device__ __forceinline__ float silu_f(float x) { return x * __builtin_amdgcn_rcpf(1.f + __builtin_amdgcn_exp2f(-1.4426950408889634f * x)); }
__device__ __forceinline__ float wave_sum(float v) {
#pragma unroll
    for (int o = 1; o < 64; o <<= 1) v += __shfl_xor(v, o);
    return v;
}
#define LDS_WAIT() asm volatile("s_waitcnt lgkmcnt(0)" ::: "memory")

struct SchedLin : pg8::StaticOrder {
    const char* A0; const char* B0; size_t sAm, sAn, sBm, sBn;
    __device__ __forceinline__ const char* aptr(const pg8::Unit& u) const { return A0 + u.pm * sAm + u.pn * sAn + (size_t)u.roff * (sAm >> 8); }
    __device__ __forceinline__ const char* bptr(const pg8::Unit& u) const { return B0 + u.pm * sBm + u.pn * sBn; }
    __device__ __forceinline__ void plain(const void* A, int lda, const void* B, int ldb) { A0 = (const char*)A; B0 = (const char*)B; sAm = (size_t)256 * lda * 2; sAn = 0; sBm = 0; sBn = (size_t)256 * ldb * 2; }
};

__device__ __forceinline__ void phase0(const Params& p, unsigned char* lds) {
    const int tid = tidx(), lane = tid & 63, wave = tid >> 6, G = gridDim.x, bid = blockIdx.x;
    float* sv = (float*)lds;
    float* red = sv + 3 * 2048;
    const float* c = p.in[1]; const float* cctx = p.in[3];
    for (int i = tid; i < 3 * 2048; i += NTHR) { const float v = i < 4096 ? c[i] : cctx[i - 4096]; sv[i] = silu_f(v); }
    __syncthreads();
    float* mod = (float*)(p.ws + WS_MOD);
    const float* ada_w = p.in[5]; const float* ada_b = p.in[6];
    typedef float f32x2 __attribute__((ext_vector_type(2)));
    for (int it = bid; it < 4 * 48; it += G) {
        const int L = it / 48, jg = it % 48;
        const float* w = ada_w + (size_t)L * 2048 * 6144 + jg * 128 + 2 * lane;
        f32x2 a0 = {0.f, 0.f}, a1 = {0.f, 0.f}, a2 = {0.f, 0.f};
#pragma unroll 16
        for (int k = wave * 256; k < wave * 256 + 256; ++k) { const f32x2 wv = __builtin_nontemporal_load((const f32x2*)(w + (size_t)k * 6144)); a0 += sv[k] * wv; a1 += sv[2048 + k] * wv; a2 += sv[4096 + k] * wv; }
        f32x2* red2 = (f32x2*)red;
        red2[(wave * 3 + 0) * 64 + lane] = a0; red2[(wave * 3 + 1) * 64 + lane] = a1; red2[(wave * 3 + 2) * 64 + lane] = a2;
        __syncthreads();
        if (tid < 192) { const int v = tid >> 6, l = tid & 63; f32x2 s = {0.f, 0.f};
#pragma unroll
            for (int w8 = 0; w8 < 8; ++w8) s += red2[(w8 * 3 + v) * 64 + l];
            const f32x2 bb = *(const f32x2*)(ada_b + L * 6144 + jg * 128 + 2 * l);
            *(f32x2*)(mod + (size_t)(L * 3 + v) * 6144 + jg * 128 + 2 * l) = s + bb; }
        __syncthreads();
    }
    const int gt = bid * NTHR + tid, NT = G * NTHR;
    float* rope = (float*)(p.ws + TAB_ROPE);
    for (int j = gt; j < 128 * 16; j += NT) { const int pos = j >> 4, i = j & 15;
        const float inv = exp2f(-(float)i * (13.287712379549449f / 16.f)); const float ang = (float)pos * inv;
        double td = (double)ang * 0.15915494309189535; td -= floor(td); const float tf = (float)td;
        rope[2 * j] = __builtin_amdgcn_cosf(tf); rope[2 * j + 1] = __builtin_amdgcn_sinf(tf); }
    bf16* DA = (bf16*)(p.ws + TAB_DA); bf16* CPM = (bf16*)(p.ws + TAB_CASPM);
    for (int j = gt; j < 256 * 128; j += NT) { const int r = j >> 7, cc = j & 127;
        { const int k1 = r & 127; const float t = (float)((k1 * cc) & 127) * (1.f / 128.f); DA[j] = (bf16)f2bf(r < 128 ? __builtin_amdgcn_cosf(t) : -__builtin_amdgcn_sinf(t)); } }
    { bf16* DC2 = (bf16*)(p.ws + TAB_DC2);
      for (int j = gt; j < 129 * 128 * 128; j += NT) { const int cc = j & 127, r = (j >> 7) & 127, k1 = (j >> 14) & 127, ty = r >> 6, k2 = r & 63, n2 = cc >> 1, ri = cc & 1;
          const float t = (float)(((128 * k2 + k1) * n2) & 8191) * (1.f / 8192.f); const float c_ = __builtin_amdgcn_cosf(t), s_ = __builtin_amdgcn_sinf(t);
          DC2[j] = (bf16)f2bf(ty == 1 ? (ri == 0 ? c_ + s_ : s_ - c_) : (ri == 0 ? c_ - s_ : s_ + c_)); } }
    for (int j = gt; j < 512 * 256; j += NT) { const int r = j >> 8, n = j & 255, k = r & 255; const float t = (float)((k * n) & 255) * (1.f / 256.f); const float c_ = __builtin_amdgcn_cosf(t), s_ = __builtin_amdgcn_sinf(t);
        CPM[j] = (bf16)f2bf(r < 256 ? c_ - s_ : c_ + s_); }
}

__device__ __forceinline__ void transpose_all(const float* W, int ldw, int K, int ncols, bf16* WT, unsigned char* lds, int vb = -1, int nvb = 0) {
    const int tid = tidx(); float* tile = (float*)lds;
    const int nblk = ncols / 256, nitems = (K / 64) * nblk;
    if (vb < 0) { vb = blockIdx.x; nvb = gridDim.x; }
    f32x4 v[8];
    int it = vb;
    if (it < nitems) { const int k0 = 64 * (it / nblk), n0 = 256 * (it % nblk);
#pragma unroll
        for (int i = 0; i < 8; ++i) { const int pc = tid + i * NTHR, kk = pc >> 6, c4 = (pc & 63) * 4; v[i] = __builtin_nontemporal_load((const f32x4*)(W + (size_t)(k0 + kk) * ldw + n0 + c4)); } }
    for (; it < nitems; it += nvb) {
        const int kb = it / nblk, nb = it % nblk, k0 = 64 * kb, n0 = 256 * nb;
        __syncthreads();
#pragma unroll
        for (int i = 0; i < 8; ++i) { const int pc = tid + i * NTHR, kk = pc >> 6, c4 = (pc & 63) * 4; *(f32x4*)(tile + kk * 260 + c4) = v[i]; }
        const int itn = it + nvb;
        if (itn < nitems) { const int k0n = 64 * (itn / nblk), n0n = 256 * (itn % nblk);
#pragma unroll
            for (int i = 0; i < 8; ++i) { const int pc = tid + i * NTHR, kk = pc >> 6, c4 = (pc & 63) * 4; v[i] = __builtin_nontemporal_load((const f32x4*)(W + (size_t)(k0n + kk) * ldw + n0n + c4)); } }
        __syncthreads();
        const int n = tid & 255, kh = (tid >> 8) * 32; const float* sp = tile + kh * 260 + n; bf16* o = WT + (size_t)(n0 + n) * K + k0 + kh;
#pragma unroll
        for (int q = 0; q < 4; ++q) { u32x4 w; w.x = pk2(sp[(8 * q) * 260], sp[(8 * q + 1) * 260]); w.y = pk2(sp[(8 * q + 2) * 260], sp[(8 * q + 3) * 260]); w.z = pk2(sp[(8 * q + 4) * 260], sp[(8 * q + 5) * 260]); w.w = pk2(sp[(8 * q + 6) * 260], sp[(8 * q + 7) * 260]);
            *(u32x4*)(o + 8 * q) = w; }
    }
    __syncthreads();
}
__device__ __forceinline__ void hartley_fold(const float* W  , bf16* WT, unsigned char* lds) {
    float* tile = (float*)lds;
    float* cas = tile + 64 * 260;
    const int tid = tidx();
    for (int it = blockIdx.x; it < 16 * 32; it += gridDim.x) {
        const int g = it >> 5, k0 = (it & 31) * 64;
        __syncthreads();
        { f32x4 v[8];
#pragma unroll
          for (int i = 0; i < 8; ++i) { const int pc = tid + i * NTHR, kk = pc >> 6, c4 = (pc & 63) * 4; v[i] = __builtin_nontemporal_load((const f32x4*)(W + (size_t)(k0 + kk) * 8192 + g * 256 + c4)); }
#pragma unroll
          for (int i = 0; i < 8; ++i) { const int pc = tid + i * NTHR, kk = pc >> 6, c4 = (pc & 63) * 4; *(f32x4*)(tile + kk * 260 + c4) = v[i]; } }
        if (tid < 256) { const float t = (float)tid * (1.f / 256.f); cas[tid] = __builtin_amdgcn_cosf(t) + __builtin_amdgcn_sinf(t); }
        __syncthreads();
        const int l0 = tid & 63, kg = (tid >> 6) * 8;
        float acc[8][4];
#pragma unroll
        for (int kk = 0; kk < 8; ++kk)
#pragma unroll
            for (int jj = 0; jj < 4; ++jj) acc[kk][jj] = 0.f;
#pragma unroll 2
        for (int cc = 0; cc < 256; ++cc) { float w[4];
#pragma unroll
            for (int jj = 0; jj < 4; ++jj) w[jj] = cas[((l0 + 64 * jj) * cc) & 255];
#pragma unroll
            for (int kk = 0; kk < 8; ++kk) { const float tv = tile[(kg + kk) * 260 + cc];
#pragma unroll
                for (int jj = 0; jj < 4; ++jj) acc[kk][jj] += tv * w[jj]; } }
#pragma unroll
        for (int jj = 0; jj < 4; ++jj) { u32x4 w; w.x = pk2(acc[0][jj], acc[1][jj]); w.y = pk2(acc[2][jj], acc[3][jj]); w.z = pk2(acc[4][jj], acc[5][jj]); w.w = pk2(acc[6][jj], acc[7][jj]);
            *(u32x4*)(WT + (size_t)(g * 256 + l0 + 64 * jj) * 2048 + k0 + kg) = w; }
    }
    __syncthreads();
}
__device__ __forceinline__ void norm_rows(const Params& p, int L, int nrows, bool perm) {
    const int lane = tidx() & 63, gw = blockIdx.x * NWAVES + (tidx() >> 6), NGW = gridDim.x * NWAVES;
    const float* gvec = p.in[4] + L * 2048; const float* mod = (const float*)(p.ws + WS_MOD) + (size_t)L * 3 * 6144;
    bf16* HB = (bf16*)(p.ws + WS_HB);
    const float* xl = L == 0 ? p.in[0] : p.out; const float* xcx = L <= 1 ? p.in[2] : (const float*)(p.ws + WS_XC);
#define NR_SRC(r) ((r) < ML ? xl + (size_t)(r) * DM : xcx + (size_t)((r) - ML) * DM)
    f32x4 x[8], xn[8];
    int row = gw;
    if (row < nrows) { const float* xr = NR_SRC(row);
#pragma unroll
        for (int j = 0; j < 8; ++j) x[j] = *(const f32x4*)(xr + 4 * lane + 256 * j); }
    for (; row < nrows; row += NGW) {
        const int rn = row + NGW;
        if (rn < nrows) { const float* xr = NR_SRC(rn);
#pragma unroll
            for (int j = 0; j < 8; ++j) xn[j] = *(const f32x4*)(xr + 4 * lane + 256 * j); }
        const int v = row < ML ? (row >> 13) : 2; const float* sh = mod + v * 6144; const float* sc = sh + 2048;
        const int orow = (perm && row < ML) ? ((row & ~8191) + ((row & 63) << 7) + ((row & 8191) >> 6)) : row;
        bool emit = true;
        if (row >= ML && L >= 1) {
            const float* gp = mod - 3 * 6144 + 2 * 6144 + 4096; const float* pp = (const float*)(p.ws + WS_PART) + (size_t)(row - ML) * 2048; float* xw = (float*)(p.ws + WS_XC) + (size_t)(row - ML) * DM;
#pragma unroll
            for (int j = 0; j < 8; ++j) { const int c0 = 4 * lane + 256 * j; f32x4 a = *(const f32x4*)(pp + c0);
#pragma unroll
                for (int ks = 1; ks < 8; ++ks) a = a + *(const f32x4*)(pp + (size_t)ks * 512 * 2048 + c0);
                x[j] = x[j] + *(const f32x4*)(gp + c0) * a; *(f32x4*)(xw + c0) = x[j];
                asm volatile("" ::: "memory"); }
            emit = L != 3;
        }
        if (emit) {
            float s = 0.f;
#pragma unroll
            for (int j = 0; j < 8; ++j) s += (x[j].x * x[j].x + x[j].y * x[j].y) + (x[j].z * x[j].z + x[j].w * x[j].w);
            const float rstd = rsqrtf(wave_sum(s) * (1.f / DM) + EPS);
#pragma unroll
            for (int j = 0; j < 8; ++j) { const int c0 = 4 * lane + 256 * j; const f32x4 g4 = *(const f32x4*)(gvec + c0), s4 = *(const f32x4*)(sc + c0), h4 = *(const f32x4*)(sh + c0);
                const f32x4 y = x[j] * rstd * g4 * (1.f + s4) + h4; u32x2 w; w.x = pk2(y.x, y.y); w.y = pk2(y.z, y.w); *(u32x2*)(HB + (size_t)orow * DM + c0) = w; }
        }
#pragma unroll
        for (int j = 0; j < 8; ++j) x[j] = xn[j];
    }
#undef NR_SRC
}
template <int L> __device__ __forceinline__ void phase_prep(const Params& p, unsigned char* lds) {
    constexpr int kind = L % 3, j = L / 3;
    bf16* WIN = (bf16*)(p.ws + WS_WIN); bf16* WOUT = (bf16*)(p.ws + WS_WOUT);
    if (kind == 0) { const float* W = p.in[8] + (size_t)j * 2048 * 8192;
        hartley_fold(W, WIN, lds);
        transpose_all(W + 4096, 8192, 2048, 4096, WIN + (size_t)4096 * 2048, lds);
        { const float* wmix = p.in[9] + (size_t)j * 16 * 65536; bf16* BM = (bf16*)(p.ws + WS_BMIX);
          for (int base = blockIdx.x * NTHR + tidx(); base < 16 * 256 * 512; base += 8 * gridDim.x * NTHR) { float v[8];
#pragma unroll
              for (int e = 0; e < 8; ++e) { const int idx = base + e * gridDim.x * NTHR; const int jj = idx & 511, d = (idx >> 9) & 255, g = idx >> 17, l = jj < 256 ? jj : ((512 - jj) & 255);
                  v[e] = idx < 16 * 256 * 512 ? wmix[(size_t)g * 65536 + l * 256 + d] : 0.f; }
#pragma unroll
              for (int e = 0; e < 8; ++e) { const int idx = base + e * gridDim.x * NTHR; if (idx < 16 * 256 * 512) BM[idx] = (bf16)f2bf(v[e]); } } }
    } else if (kind == 1) transpose_all(p.in[10], 9216, 2048, 9216, WIN, lds);
    else { transpose_all(p.in[12], 12288, 2048, 12288, WIN, lds);
        bf16* WSB = (bf16*)(p.ws + WS_WSB); const float* wsp = p.in[13];
        for (int idx = blockIdx.x * NTHR + tidx(); idx < 16 * 128 * 128; idx += gridDim.x * NTHR) WSB[idx] = (bf16)f2bf(wsp[idx]); }
    transpose_all(p.in[7] + (size_t)L * 4096 * 2048, 2048, 4096, 2048, WOUT, lds);
    norm_rows(p, L, MT, kind == 0);
}

struct SchedCtxOut : pg8::StaticOrder {
    const char* A0; const char* B0;
    __device__ __forceinline__ const char* aptr(const pg8::Unit& u) const { return A0 + (size_t)u.pm * (256 * 4096 * 2) + (u.pn >> 3) * 1024; }
    __device__ __forceinline__ const char* bptr(const pg8::Unit& u) const { return B0 + (size_t)(u.pn & 7) * (256 * 4096 * 2) + (u.pn >> 3) * 1024; }
};
template <int L> __device__ __forceinline__ void phase_outproj(const Params& p, unsigned char* lds) {
    const unsigned char* Y = p.ws + (L % 3 == 0 ? WS_YB_F : (L % 3 == 1 ? WS_YB : WS_UG));
    { pg8::Gemm g{DBR, DBR, DBR};
      SchedLin S; S.init(ML, DM, gridDim.x, blockIdx.x); S.plain(Y, DBR, p.ws + WS_WOUT, DBR);
      pg8::EpiResid E{L == 0 ? p.in[0] : p.out, p.out, (const float*)(p.ws + WS_MOD) + (size_t)L * 3 * 6144};
      pg8::gemm_phase<pg8::EpiResid, SchedLin>((PG8_LAS unsigned char*)lds, g, S, E); }
    if (L < 3) {
        pg8::Gemm g{DBR, DBR, 512};
        SchedCtxOut S; S.init(MC, 64 * 256, gridDim.x, blockIdx.x); S.A0 = (const char*)(Y + (size_t)ML * DBR * 2); S.B0 = (const char*)(p.ws + WS_WOUT);
        pg8::EpiPart E{(float*)(p.ws + WS_PART)};
        pg8::gemm_phase<pg8::EpiPart, SchedCtxOut>((PG8_LAS unsigned char*)lds, g, S, E);
    }
}

using pg8::Unit;
__device__ __forceinline__ u32x4 pack8(const pg8::f32x4& a, const pg8::f32x4& b) { u32x4 w; w.x = pg8::cvt_pk_bf16(a[0], a[1]); w.y = pg8::cvt_pk_bf16(a[2], a[3]); w.z = pg8::cvt_pk_bf16(b[0], b[1]); w.w = pg8::cvt_pk_bf16(b[2], b[3]); return w; }
struct SchedFnetIn : pg8::StaticOrder {
    const char* HBp; const char* WINp;
    __device__ __forceinline__ const char* aptr(const Unit& u) const { return (u.pn < 16 ? WINp + (size_t)u.pn * (256 * 2048 * 2) : HBp + (size_t)u.pm * (256 * 2048 * 2)) + (size_t)u.roff * (2048 * 2); }
    __device__ __forceinline__ const char* bptr(const Unit& u) const { return u.pn < 16 ? HBp + (size_t)u.pm * (256 * 2048 * 2) : WINp + (size_t)u.pn * (256 * 2048 * 2); }
};
struct EpiFnetIn {
    static constexpr bool PERM = true;
    unsigned char* ws;
    __device__ __forceinline__ void operator()(const pg8::f32x4 (&acc)[2][2][4][2], const Unit& u, int wr, int wc, int fr, int fq) const {
        bf16* const U1 = (bf16*)(ws + WS_U1); bf16* const UCT = (bf16*)(ws + WS_UCT); bf16* const ZB = (bf16*)(ws + WS_ZB);
        { int t_ = tidx(); fr = t_ & 15; fq = (t_ >> 4) & 3; }
        if (u.pn < 16) {
#pragma unroll
            for (int ai = 0; ai < 2; ++ai)
#pragma unroll
                for (int m = 0; m < 4; ++m) { if (ai >= u.na) break; const int c = u.pn * 256 + u.roff + ai * 128 + wr * 64 + m * 16 + fr;
#pragma unroll
                    for (int bj = 0; bj < 2; ++bj) { const int tcol = bj * 128 + wc * 32 + 8 * fq; bf16* dst;
                        if (u.pm < 64) { const int rp = u.pm * 256 + tcol, b = rp >> 13, r = rp & 8191, n2 = r >> 7, n1 = r & 127; dst = U1 + ((size_t)(b * 4096 + c) * 64 + n2) * 128 + n1; }
                        else dst = UCT + ((size_t)((u.pm - 64) * 4096 + c) * 256 + tcol);
                        *(u32x4*)dst = pack8(acc[ai][bj][m][0], acc[ai][bj][m][1]); } }
        } else {
#pragma unroll
            for (int ai = 0; ai < 2; ++ai)
#pragma unroll
                for (int m = 0; m < 4; ++m) { if (ai >= u.na) break; const int rp = u.pm * 256 + u.roff + ai * 128 + wr * 64 + m * 16 + fr; int row = rp;
                    if (rp < ML) { const int r = rp & 8191; row = (rp & ~8191) + ((r & 127) << 6) + (r >> 7); }
#pragma unroll
                    for (int bj = 0; bj < 2; ++bj) { const int zc = (u.pn - 16) * 256 + bj * 128 + wc * 32 + 8 * fq; pg8::f32x4 a = acc[ai][bj][m][0], b = acc[ai][bj][m][1];
#pragma unroll
                        for (int e = 0; e < 4; ++e) { a[e] = silu_f(a[e]); b[e] = silu_f(b[e]); }
                        *(u32x4*)(ZB + (size_t)row * 4096 + zc) = pack8(a, b); } }
        }
    }
};
template <int L> __device__ __forceinline__ void phase_inproj_fnet(const Params& p, unsigned char* lds) {
    constexpr int M = L == 3 ? ML : MT;
    pg8::Gemm g{DM, DM, DM};
    SchedFnetIn S; S.init(M, 8192, gridDim.x, blockIdx.x, true); S.HBp = (const char*)(p.ws + WS_HB); S.WINp = (const char*)(p.ws + WS_WIN);
    EpiFnetIn E{p.ws};
    pg8::gemm_phase<EpiFnetIn, SchedFnetIn>((PG8_LAS unsigned char*)lds, g, S, E);
}
struct EpiStageA {
    static constexpr bool PERM = true;
    bf16* YP;
    __device__ __forceinline__ void operator()(const pg8::f32x4 (&acc)[2][2][4][2], const Unit& u, int wr, int wc, int fr, int fq) const {
        { int t_ = tidx(); fr = t_ & 15; fq = (t_ >> 4) & 3; }
#pragma unroll
        for (int m = 0; m < 4; ++m) { const int k1 = wr * 64 + m * 16 + fr;
#pragma unroll
            for (int bj = 0; bj < 2; ++bj) { const int idx = u.pn * 256 + bj * 128 + wc * 32 + 8 * fq, n2 = idx & 63, c = (idx >> 6) & 4095, b = idx >> 18;
                bf16* dst = YP + ((((size_t)(b * 128 + k1) * 4096 + c) * 64 + n2) << 1);
#pragma unroll
                for (int h = 0; h < 2; ++h) { const pg8::f32x4 re = acc[0][bj][m][h], im = acc[1][bj][m][h];
                    u32x4 w; w.x = pg8::cvt_pk_bf16(re[0], im[0]); w.y = pg8::cvt_pk_bf16(re[1], im[1]); w.z = pg8::cvt_pk_bf16(re[2], im[2]); w.w = pg8::cvt_pk_bf16(re[3], im[3]);
                    *(u32x4*)(dst + 8 * h) = w; } } }
    }
};
struct EpiCtxH {
    static constexpr bool PERM = true;
    bf16* TO;
    __device__ __forceinline__ void operator()(const pg8::f32x4 (&acc)[2][2][4][2], const Unit& u, int wr, int wc, int fr, int fq) const {
        { int t_ = tidx(); fr = t_ & 15; fq = (t_ >> 4) & 3; }
        const int b = u.pn >> 4, g = u.pn & 15;
#pragma unroll
        for (int ai = 0; ai < 2; ++ai)
#pragma unroll
            for (int m = 0; m < 4; ++m) { const int k = ai * 128 + wr * 64 + m * 16 + fr;
#pragma unroll
                for (int bj = 0; bj < 2; ++bj) { const int l = bj * 128 + wc * 32 + 8 * fq;
                    *(u32x4*)(TO + ((size_t)(ML + b * 256 + k) * 16 + g) * 512 + u.pm * 256 + l) = pack8(acc[ai][bj][m][0], acc[ai][bj][m][1]); } }
    }
};
__device__ __forceinline__ void phase_fnet_a(const Params& p, bool ctx, unsigned char* lds) {
    if (ctx) {
        pg8::Gemm g{256, 256, 256};
        SchedLin S; S.init(512, 8192, gridDim.x, blockIdx.x); S.A0 = (const char*)(p.ws + TAB_CASPM); S.B0 = (const char*)(p.ws + WS_UCT); S.sAm = 256 * 256 * 2; S.sAn = 0; S.sBm = 0; S.sBn = 256 * 256 * 2;
        EpiCtxH E{(bf16*)(p.ws + WS_TO)};
        pg8::gemm_phase<EpiCtxH, SchedLin>((PG8_LAS unsigned char*)lds, g, S, E);
    }
    pg8::Gemm g{128, 128, 128};
    SchedLin S; S.init(256, 2 * 4096 * 64, gridDim.x, blockIdx.x); S.A0 = (const char*)(p.ws + TAB_DA); S.B0 = (const char*)(p.ws + WS_U1); S.sAm = 0; S.sAn = 0; S.sBm = 0; S.sBn = 256 * 128 * 2;
    EpiStageA E{(bf16*)(p.ws + WS_YP)};
    pg8::gemm_phase<EpiStageA, SchedLin>((PG8_LAS unsigned char*)lds, g, S, E);
}
struct EpiStageC {
    static constexpr bool PERM = true;
    bf16* TO;
    __device__ __forceinline__ void operator()(const pg8::f32x4 (&acc)[2][2][4][2], const Unit& u, int wr, int wc, int fr, int fq) const {
        { int t_ = tidx(); fr = t_ & 15; fq = (t_ >> 4) & 3; }
        const int idx = u.pn * 256, g = (idx & 4095) >> 8, k1 = (idx >> 12) & 127, b = idx >> 19;
#pragma unroll
        for (int m = 0; m < 4; ++m) { const int k2 = m * 16 + fr; const size_t row = (size_t)b * 8192 + k1 + 128 * k2;
#pragma unroll
            for (int bj = 0; bj < 2; ++bj) { const int l = bj * 128 + wc * 32 + 8 * fq;
                *(u32x4*)(TO + (row * 16 + g) * 512 + wr * 256 + l) = pack8(acc[0][bj][m][0], acc[0][bj][m][1]); } }
    }
};
struct SchedStageC : pg8::StaticOrder {
    const char* A0; const char* B0; size_t sBn;
    __device__ __forceinline__ const char* aptr(const Unit& u) const { return A0 + (size_t)((u.pn >> 4) & 127) * (128 * 128 * 2); }
    __device__ __forceinline__ const char* bptr(const Unit& u) const { return B0 + u.pn * sBn; }
};
__device__ __forceinline__ void phase_fnet_c(const Params& p, unsigned char* lds) {
    pg8::Gemm g{128, 128, 128};
    SchedStageC S; S.init(256, 2 * 128 * 4096, gridDim.x, blockIdx.x); S.A0 = (const char*)(p.ws + TAB_DC2); S.B0 = (const char*)(p.ws + WS_YP); S.sBn = 256 * 128 * 2;
    EpiStageC E{(bf16*)(p.ws + WS_TO)};
    pg8::gemm_phase<EpiStageC, SchedStageC, true>((PG8_LAS unsigned char*)lds, g, S, E);
}
struct EpiMix {
    static constexpr bool PERM = true;
    const bf16* ZB; bf16* YB;
    __device__ __forceinline__ void operator()(const pg8::f32x4 (&acc)[2][2][4][2], const Unit& u, int wr, int wc, int fr, int fq) const {
        { int t_ = tidx(); fr = t_ & 15; fq = (t_ >> 4) & 3; }
#pragma unroll
        for (int ai = 0; ai < 2; ++ai) {
            if (ai >= u.na) break;
            u32x4 zv[4][2];
#pragma unroll
            for (int m = 0; m < 4; ++m)
#pragma unroll
                for (int bj = 0; bj < 2; ++bj) zv[m][bj] = *(const u32x4*)(ZB + (size_t)(u.pm * 256 + u.roff + ai * 128 + wr * 64 + m * 16 + fr) * 4096 + u.pn * 256 + bj * 128 + wc * 32 + 8 * fq);
#pragma unroll
            for (int m = 0; m < 4; ++m) { const int row = u.pm * 256 + u.roff + ai * 128 + wr * 64 + m * 16 + fr; const float sc = row < ML ? 0.5f * 6.9053396600248786e-4f : 0.5f / 256.f;
#pragma unroll
                for (int bj = 0; bj < 2; ++bj) { const size_t off = (size_t)row * 4096 + u.pn * 256 + bj * 128 + wc * 32 + 8 * fq;
                    const u32x4 z = zv[m][bj]; pg8::f32x4 a = acc[ai][bj][m][0] * sc, b = acc[ai][bj][m][1] * sc;
                    a[0] *= __uint_as_float(z.x << 16); a[1] *= __uint_as_float(z.x & 0xffff0000u); a[2] *= __uint_as_float(z.y << 16); a[3] *= __uint_as_float(z.y & 0xffff0000u);
                    b[0] *= __uint_as_float(z.z << 16); b[1] *= __uint_as_float(z.z & 0xffff0000u); b[2] *= __uint_as_float(z.w << 16); b[3] *= __uint_as_float(z.w & 0xffff0000u);
                    *(u32x4*)(YB + off) = pack8(a, b); } }
            asm volatile("" ::: "memory");
        }
    }
};
template <int L> __device__ __forceinline__ void phase_fnet_mix(const Params& p, unsigned char* lds) {
    constexpr int M = L == 3 ? ML : MT;
    pg8::Gemm g{8192, 512, 512};
    SchedLin S; S.init(M, 4096, gridDim.x, blockIdx.x, true); S.A0 = (const char*)(p.ws + WS_TO); S.B0 = (const char*)(p.ws + WS_BMIX); S.sAm = (size_t)256 * 8192 * 2; S.sAn = 512 * 2; S.sBm = 0; S.sBn = 256 * 512 * 2;
    EpiMix E{(const bf16*)(p.ws + WS_ZB), (bf16*)(p.ws + WS_YB_F)};
    pg8::gemm_phase<EpiMix, SchedLin>((PG8_LAS unsigned char*)lds, g, S, E);
}

struct SchedAttnIn : pg8::StaticOrder {
    const char* HBp; const char* WINp;
    __device__ __forceinline__ const char* aptr(const Unit& u) const { return ((u.pn == 18 || u.pn == 19) ? WINp + (size_t)u.pn * (256 * 2048 * 2) : HBp + (size_t)u.pm * (256 * 2048 * 2)) + (size_t)u.roff * (2048 * 2); }
    __device__ __forceinline__ const char* bptr(const Unit& u) const { return (u.pn == 18 || u.pn == 19) ? HBp + (size_t)u.pm * (256 * 2048 * 2) : WINp + (size_t)u.pn * (256 * 2048 * 2); }
};
__device__ __forceinline__ u32x2 pack4(const pg8::f32x4& a) { u32x2 w; w.x = pg8::cvt_pk_bf16(a[0], a[1]); w.y = pg8::cvt_pk_bf16(a[2], a[3]); return w; }
struct EpiAttnIn {
    static constexpr bool PERM = false;
    unsigned char* ws;
    __device__ __forceinline__ void operator()(const pg8::f32x4 (&acc)[2][2][4][2], const Unit& u, int wr, int wc, int fr, int fq) const {
        { int t_ = tidx(); fr = t_ & 15; fq = (t_ >> 4) & 3; }
        if (u.pn < 18) {
            const bool isq = u.pn < 16; bf16* const O = isq ? (bf16*)(ws + WS_QB) : (bf16*)(ws + WS_KB); const int ldo = isq ? 4096 : 512; const int cb = (isq ? u.pn : u.pn - 16) * 256 + wc * 32 + 4 * fq;
            const float sc = isq ? 0.125f * 1.4426950408889634f : 1.f; const float* rope = (const float*)(ws + TAB_ROPE);
#pragma unroll
            for (int ai = 0; ai < 2; ++ai)
#pragma unroll
                for (int m = 0; m < 4; ++m) { if (ai >= u.na) break; const int row = u.pm * 256 + u.roff + ai * 128 + wr * 64 + m * 16 + fr;
                    pg8::f32x4 c4 = (pg8::f32x4){1.f, 1.f, 1.f, 1.f}, s4 = (pg8::f32x4){0.f, 0.f, 0.f, 0.f};
                    if (row < ML) { const int t = row & 8191, pos = (wc & 1) ? (t & 63) : (t >> 6); const pg8::f32x4 r0 = *(const pg8::f32x4*)(rope + 2 * (pos * 16 + 4 * fq)), r1 = *(const pg8::f32x4*)(rope + 2 * (pos * 16 + 4 * fq) + 4);
                        c4 = (pg8::f32x4){r0[0], r0[2], r1[0], r1[2]}; s4 = (pg8::f32x4){r0[1], r0[3], r1[1], r1[3]}; }
#pragma unroll
                    for (int bj = 0; bj < 2; ++bj) { const pg8::f32x4 x1 = acc[ai][bj][m][0], x2 = acc[ai][bj][m][1];
                        const pg8::f32x4 y1 = (x1 * c4 - x2 * s4) * sc, y2 = (x1 * s4 + x2 * c4) * sc; bf16* o = O + (size_t)row * ldo + cb + bj * 128;
                        *(u32x2*)o = pack4(y1); *(u32x2*)(o + 16) = pack4(y2); }
                    if (m == 3) asm volatile("" ::: "memory"); }
        } else if (u.pn < 20) {
#pragma unroll
            for (int ai = 0; ai < 2; ++ai)
#pragma unroll
                for (int m = 0; m < 4; ++m) { if (ai >= u.na) break; const int ch = (u.pn - 18) * 256 + u.roff + ai * 128 + wr * 64 + m * 16 + fr;
#pragma unroll
                    for (int bj = 0; bj < 2; ++bj)
#pragma unroll
                        for (int n = 0; n < 2; ++n) { const int tcol = bj * 128 + wc * 32 + n * 16 + 4 * fq; bf16* dst;
                            if (u.pm < 64) { const int tk = u.pm * 256 + tcol; dst = (bf16*)(ws + WS_VT) + ((size_t)((tk >> 13) * 512 + ch) * 8192 + (tk & 8191)); }
                            else dst = (bf16*)(ws + WS_VTC) + ((size_t)((u.pm - 64) * 512 + ch) * 256 + tcol);
                            *(u32x2*)dst = pack4(acc[ai][bj][m][n]); } }
        } else {
            bf16* const ZB = (bf16*)(ws + WS_ZA);
#pragma unroll
            for (int ai = 0; ai < 2; ++ai)
#pragma unroll
                for (int m = 0; m < 4; ++m) { if (ai >= u.na) break; const int row = u.pm * 256 + u.roff + ai * 128 + wr * 64 + m * 16 + fr;
#pragma unroll
                    for (int bj = 0; bj < 2; ++bj)
#pragma unroll
                        for (int n = 0; n < 2; ++n) { pg8::f32x4 a = acc[ai][bj][m][n];
#pragma unroll
                            for (int e = 0; e < 4; ++e) a[e] = silu_f(a[e]);
                            *(u32x2*)(ZB + (size_t)row * 4096 + (u.pn - 20) * 256 + bj * 128 + wc * 32 + n * 16 + 4 * fq) = pack4(a); } }
        }
    }
};
__device__ __forceinline__ void phase_inproj_attn(const Params& p, unsigned char* lds) {
    pg8::Gemm g{DM, DM, DM};
    SchedAttnIn S; S.init(MT, 9216, gridDim.x, blockIdx.x, true); S.HBp = (const char*)(p.ws + WS_HB); S.WINp = (const char*)(p.ws + WS_WIN);
    EpiAttnIn E{p.ws};
    pg8::gemm_phase<EpiAttnIn, SchedAttnIn>((PG8_LAS unsigned char*)lds, g, S, E);
}
typedef short bf16x8_t __attribute__((ext_vector_type(8)));
typedef float f32x16 __attribute__((ext_vector_type(16)));
#define MFMA32(a, b, c) __builtin_amdgcn_mfma_f32_32x32x16_bf16((a), (b), (c), 0, 0, 0)
__device__ __forceinline__ bf16x8_t pack_step(const f32x16& x, int s) {
    u32x4 q;
    asm volatile("s_nop 3\n\tv_cvt_pk_bf16_f32 %0, %4, %5\n\tv_cvt_pk_bf16_f32 %1, %6, %7\n\tv_cvt_pk_bf16_f32 %2, %8, %9\n\tv_cvt_pk_bf16_f32 %3, %10, %11\n\ts_nop 1"
                 : "=&v"(q[0]), "=&v"(q[1]), "=&v"(q[2]), "=&v"(q[3])
                 : "v"(x[8 * s]), "v"(x[8 * s + 1]), "v"(x[8 * s + 2]), "v"(x[8 * s + 3]), "v"(x[8 * s + 4]), "v"(x[8 * s + 5]), "v"(x[8 * s + 6]), "v"(x[8 * s + 7]));
    return __builtin_bit_cast(bf16x8_t, q);
}
__device__ __forceinline__ void phase_attn(const Params& p, unsigned char* lds) {
    const int tid = tidx(), lane = tid & 63, wave = __builtin_amdgcn_readfirstlane(tid >> 6), r = lane & 31, h = lane >> 5;
    const bf16* QB = (const bf16*)(p.ws + WS_QB); const bf16* KB = (const bf16*)(p.ws + WS_KB); const bf16* VT = (const bf16*)(p.ws + WS_VT); const bf16* VTC = (const bf16*)(p.ws + WS_VTC);
    const bf16* ZB = (const bf16*)(p.ws + WS_ZA); bf16* YB = (bf16*)(p.ws + WS_YB); const float* sink = p.in[11];
    const int sk = tid >> 3, sp = tid & 7;
    constexpr int BUF = 18432, VOFF = 9216, RS = 144;
    for (int item = blockIdx.x; item < 2112; item += gridDim.x) {
        int b, kvh, q0, qrow0, cfirst, nw;
        if (item < 2048) { b = item >> 10; kvh = (item >> 7) & 7; q0 = (item & 127) * 64; qrow0 = b * 8192 + q0;
            cfirst = q0 < 128 ? (128 - q0) >> 6 : 0; const int clast = q0 > 8000 ? (8256 - q0) >> 6 : 4; nw = clast - cfirst + 1; }
        else { const int i2 = item - 2048; b = i2 >> 5; kvh = (i2 >> 2) & 7; q0 = (i2 & 3) * 64; qrow0 = ML + b * 256 + q0; cfirst = 0; nw = 0; }
        const int nch = nw + 4, hq = kvh * 8 + wave;
        bf16x8_t Qf[2][4];
#pragma unroll
        for (int sb = 0; sb < 2; ++sb)
#pragma unroll
            for (int st = 0; st < 4; ++st) Qf[sb][st] = *(const bf16x8_t*)((const char*)QB + (size_t)(unsigned)(((qrow0 + sb * 32 + r) * 4096 + hq * 64 + 16 * st + 8 * h) * 2));
        float mrun[2], lrun[2]; f32x16 O[2][2];
#pragma unroll
        for (int sb = 0; sb < 2; ++sb) { mrun[sb] = sink[hq] * 1.4426950408889634f; lrun[sb] = h == 0 ? 1.f : 0.f;
#pragma unroll
            for (int dt = 0; dt < 2; ++dt)
#pragma unroll
                for (int i = 0; i < 16; ++i) O[sb][dt][i] = 0.f; }
        u32x4 kreg, vreg;
#define ATT_SRC(j, kp_, vp_) do { if ((j) < nw) { const int kpos0_ = q0 - 128 + 64 * (cfirst + (j)); kp_ = (const char*)KB + (size_t)(unsigned)((((b * 8192 + kpos0_ + sk) * 512) + kvh * 64 + sp * 8) * 2); vp_ = (const char*)VT + (size_t)(unsigned)((((b * 512 + kvh * 64 + sk) * 8192) + kpos0_ + sp * 8) * 2); } \
        else { const int kc = 64 * ((j) - nw); kp_ = (const char*)KB + (size_t)(unsigned)((((ML + b * 256 + kc + sk) * 512) + kvh * 64 + sp * 8) * 2); vp_ = (const char*)VTC + (size_t)(unsigned)((((b * 512 + kvh * 64 + sk) * 256) + kc + sp * 8) * 2); } } while (0)
        { const char* kp; const char* vp; ATT_SRC(0, kp, vp); kreg = *(const u32x4*)kp; vreg = *(const u32x4*)vp;
          *(u32x4*)(lds + sk * RS + sp * 16) = kreg; *(u32x4*)(lds + VOFF + sk * RS + sp * 16) = vreg; }
        __syncthreads();
        for (int j = 0; j < nch; ++j) {
            const bool more = j + 1 < nch;
            if (more) { const char* kp; const char* vp; ATT_SRC(j + 1, kp, vp); kreg = *(const u32x4*)kp; vreg = *(const u32x4*)vp; }
            const unsigned char* Kb = lds + (j & 1) * BUF; const unsigned char* Vb = Kb + VOFF;
            const int cw = cfirst + j; const bool mlo = (j < nw) && cw == 0, mhi = (j < nw) && cw == 4; const int kpos0 = q0 - 128 + 64 * cw;
            f32x16 sc[2][2];
#pragma unroll
            for (int sb = 0; sb < 2; ++sb) {
#pragma unroll
                for (int i = 0; i < 16; ++i) { sc[sb][0][i] = 0.f; sc[sb][1][i] = 0.f; }
#pragma unroll
                for (int st = 0; st < 4; ++st) { const bf16x8_t k0 = *(const bf16x8_t*)(Kb + r * RS + (16 * st + 8 * h) * 2), k1 = *(const bf16x8_t*)(Kb + (32 + r) * RS + (16 * st + 8 * h) * 2);
                    sc[sb][0] = MFMA32(k0, Qf[sb][st], sc[sb][0]); sc[sb][1] = MFMA32(k1, Qf[sb][st], sc[sb][1]); }
            }
#pragma unroll
            for (int sb = 0; sb < 2; ++sb) {
                f32x16& s0 = sc[sb][0]; f32x16& s1 = sc[sb][1];
                if (mlo || mhi) { const int qpos = q0 + sb * 32 + r, lo_t = mlo ? qpos - 128 : -(1 << 30), hi_t = mhi ? qpos + 128 : (1 << 30);
#pragma unroll
                    for (int i = 0; i < 16; ++i) { const int kp0 = kpos0 + (i & 3) + 8 * (i >> 2) + 4 * h, kp1 = kp0 + 32;
                        s0[i] = (kp0 < lo_t || kp0 > hi_t) ? -1e30f : s0[i]; s1[i] = (kp1 < lo_t || kp1 > hi_t) ? -1e30f : s1[i]; } }
                float mx = fmaxf(s0[0], s1[0]);
#pragma unroll
                for (int i = 1; i < 16; ++i) mx = fmaxf(mx, fmaxf(s0[i], s1[i]));
                mx = fmaxf(mx, __shfl_xor(mx, 32));
                const float mn = fmaxf(mrun[sb], mx), al = __builtin_amdgcn_exp2f(mrun[sb] - mn); mrun[sb] = mn;
                float rs = 0.f;
#pragma unroll
                for (int i = 0; i < 16; ++i) { s0[i] = __builtin_amdgcn_exp2f(s0[i] - mn); s1[i] = __builtin_amdgcn_exp2f(s1[i] - mn); rs += s0[i] + s1[i]; }
                lrun[sb] = lrun[sb] * al + rs;
#pragma unroll
                for (int dt = 0; dt < 2; ++dt)
#pragma unroll
                    for (int i = 0; i < 16; ++i) O[sb][dt][i] *= al;
#pragma unroll
                for (int kt = 0; kt < 2; ++kt)
#pragma unroll
                    for (int st = 0; st < 2; ++st) { const bf16x8_t pf = pack_step(kt ? s1 : s0, st);
#pragma unroll
                        for (int dt = 0; dt < 2; ++dt) { const unsigned char* va = Vb + (32 * dt + r) * RS + (32 * kt + 16 * st + 4 * h) * 2;
                            const u32x2 v0 = *(const u32x2*)va, v1 = *(const u32x2*)(va + 16); u32x4 vv; vv.x = v0.x; vv.y = v0.y; vv.z = v1.x; vv.w = v1.y;
                            O[sb][dt] = MFMA32(__builtin_bit_cast(bf16x8_t, vv), pf, O[sb][dt]); } }
            }
            if (more) { unsigned char* nb = lds + ((j + 1) & 1) * BUF; *(u32x4*)(nb + sk * RS + sp * 16) = kreg; *(u32x4*)(nb + VOFF + sk * RS + sp * 16) = vreg; }
            __syncthreads();
        }
#undef ATT_SRC
        u32x2 zv[2][2][4];
#pragma unroll
        for (int sb = 0; sb < 2; ++sb) { const unsigned rowoff = (unsigned)((qrow0 + sb * 32 + r) * 4096 + hq * 64);
#pragma unroll
            for (int dt = 0; dt < 2; ++dt)
#pragma unroll
                for (int g4 = 0; g4 < 4; ++g4) zv[sb][dt][g4] = *(const u32x2*)(ZB + (size_t)(rowoff + 32 * dt + 8 * g4 + 4 * h)); }
#pragma unroll
        for (int sb = 0; sb < 2; ++sb) { const float lt = lrun[sb] + __shfl_xor(lrun[sb], 32), il = __builtin_amdgcn_rcpf(lt); const unsigned rowoff = (unsigned)((qrow0 + sb * 32 + r) * 4096 + hq * 64);
#pragma unroll
            for (int dt = 0; dt < 2; ++dt)
#pragma unroll
                for (int g4 = 0; g4 < 4; ++g4) { const size_t off = (size_t)(rowoff + 32 * dt + 8 * g4 + 4 * h); const u32x2 z = zv[sb][dt][g4];
                    const float y0 = O[sb][dt][4 * g4 + 0] * il * __uint_as_float(z.x << 16), y1 = O[sb][dt][4 * g4 + 1] * il * __uint_as_float(z.x & 0xffff0000u);
                    const float y2 = O[sb][dt][4 * g4 + 2] * il * __uint_as_float(z.y << 16), y3 = O[sb][dt][4 * g4 + 3] * il * __uint_as_float(z.y & 0xffff0000u);
                    u32x2 w; w.x = pg8::cvt_pk_bf16(y0, y1); w.y = pg8::cvt_pk_bf16(y2, y3); *(u32x2*)(YB + off) = w; } }
    }
}

__device__ __forceinline__ float gelu_fast(float x) { const float u = x * (1.5957691216057308f + 0.07135481627159768f * x * x); return x * __builtin_amdgcn_rcpf(1.f + __builtin_amdgcn_exp2f(-1.4426950408889634f * u)); }
struct EpiGmlpIn {
    static constexpr bool PERM = true;
    unsigned char* ws;
    __device__ __forceinline__ void operator()(const pg8::f32x4 (&acc)[2][2][4][2], const Unit& u, int wr, int wc, int fr, int fq) const {
        { int t_ = tidx(); fr = t_ & 15; fq = (t_ >> 4) & 3; }
        const int kind = u.pn >> 4; bf16* const O = (bf16*)(ws + (kind == 0 ? WS_UG : (kind == 1 ? WS_VG : WS_ZG))); const int cb = (u.pn & 15) * 256 + wc * 32 + 8 * fq;
#pragma unroll
        for (int ai = 0; ai < 2; ++ai)
#pragma unroll
            for (int m = 0; m < 4; ++m) { if (ai >= u.na) break; const int row = u.pm * 256 + u.roff + ai * 128 + wr * 64 + m * 16 + fr; float s1 = 0.f, s2 = 0.f;
#pragma unroll
                for (int bj = 0; bj < 2; ++bj) { pg8::f32x4 a = acc[ai][bj][m][0], b = acc[ai][bj][m][1];
                    if (kind == 2) {
#pragma unroll
                        for (int e = 0; e < 4; ++e) { a[e] = silu_f(a[e]); b[e] = silu_f(b[e]); } }
                    else {
#pragma unroll
                        for (int e = 0; e < 4; ++e) { a[e] = gelu_fast(a[e]); b[e] = gelu_fast(b[e]); s1 += a[e] + b[e]; s2 += a[e] * a[e] + b[e] * b[e]; } }
                    *(u32x4*)(O + (size_t)row * 4096 + cb + bj * 128) = pack8(a, b); }
                if (kind == 1) { s1 += __shfl_xor(s1, 16); s1 += __shfl_xor(s1, 32); s2 += __shfl_xor(s2, 16); s2 += __shfl_xor(s2, 32);
                    if (fq == 0) { float* st = (float*)(ws + WS_STAT) + ((size_t)row * 64 + (u.pn - 16) * 4 + wc) * 2; st[0] = s1; st[1] = s2; } } }
    }
};
__device__ __forceinline__ void phase_inproj_gmlp(const Params& p, unsigned char* lds) {
    pg8::Gemm g{DM, DM, DM};
    SchedLin S; S.init(MT, 12288, gridDim.x, blockIdx.x, true); S.plain(p.ws + WS_HB, DM, p.ws + WS_WIN, DM);
    EpiGmlpIn E{p.ws};
    pg8::gemm_phase<EpiGmlpIn, SchedLin>((PG8_LAS unsigned char*)lds, g, S, E);
}
template <int NTOK> __device__ __forceinline__ void gmlp_ln_item(const Params& p, unsigned char* lds, int chunk, int toff) {
    const int tid = tidx();
    float* mr = (float*)lds;
    bf16* T = (bf16*)(lds + 1024);
    const bf16* VG = (const bf16*)(p.ws + WS_VG); bf16* VT2 = (bf16*)(p.ws + WS_VT2); const float* STAT = (const float*)(p.ws + WS_STAT);
    const float* lg = p.in[15]; const float* lb = p.in[16];
    const int row0 = chunk * 128 + toff;
    __syncthreads();
    { const int t = tid >> 3, q = tid & 7;
      if (t < NTOK) { const float* st = STAT + ((size_t)(row0 + t) * 64 + q * 8) * 2; float s1 = 0.f, s2 = 0.f;
#pragma unroll
          for (int e = 0; e < 8; ++e) { s1 += st[2 * e]; s2 += st[2 * e + 1]; }
          s1 += __shfl_xor(s1, 1); s1 += __shfl_xor(s1, 2); s1 += __shfl_xor(s1, 4); s2 += __shfl_xor(s2, 1); s2 += __shfl_xor(s2, 2); s2 += __shfl_xor(s2, 4);
          if (q == 0) { const float mu = s1 * (1.f / 4096.f); const float var = fmaxf(s2 * (1.f / 4096.f) - mu * mu, 0.f); mr[2 * t] = mu; mr[2 * t + 1] = rsqrtf(var + EPS); } } }
    __syncthreads();
    u32x4 wv[NTOK / 16], wn[NTOK / 16];
#pragma unroll
    for (int i = 0; i < NTOK / 16; ++i) { const int pc = tid + i * NTHR, t = pc >> 5, c8 = (pc & 31) * 8; wv[i] = *(const u32x4*)(VG + (size_t)(row0 + t) * 4096 + c8); }
    for (int g = 0; g < 16; ++g) {
        if (g < 15) {
#pragma unroll
            for (int i = 0; i < NTOK / 16; ++i) { const int pc = tid + i * NTHR, t = pc >> 5, c8 = (pc & 31) * 8; wn[i] = *(const u32x4*)(VG + (size_t)(row0 + t) * 4096 + (g + 1) * 256 + c8); } }
#pragma unroll
        for (int i = 0; i < NTOK / 16; ++i) { const int pc = tid + i * NTHR, t = pc >> 5, c8 = (pc & 31) * 8; const u32x4 w = wv[i];
            const float mu = mr[2 * t], rs = mr[2 * t + 1]; const f32x4 g0 = *(const f32x4*)(lg + g * 256 + c8), g1 = *(const f32x4*)(lg + g * 256 + c8 + 4), b0 = *(const f32x4*)(lb + g * 256 + c8), b1 = *(const f32x4*)(lb + g * 256 + c8 + 4);
            u32x4 o; o.x = pk2((__uint_as_float(w.x << 16) - mu) * rs * g0.x + b0.x, (__uint_as_float(w.x & 0xffff0000u) - mu) * rs * g0.y + b0.y);
            o.y = pk2((__uint_as_float(w.y << 16) - mu) * rs * g0.z + b0.z, (__uint_as_float(w.y & 0xffff0000u) - mu) * rs * g0.w + b0.w);
            o.z = pk2((__uint_as_float(w.z << 16) - mu) * rs * g1.x + b1.x, (__uint_as_float(w.z & 0xffff0000u) - mu) * rs * g1.y + b1.y);
            o.w = pk2((__uint_as_float(w.w << 16) - mu) * rs * g1.z + b1.z, (__uint_as_float(w.w & 0xffff0000u) - mu) * rs * g1.w + b1.w);
            *(u32x4*)(T + t * 264 + c8) = o; }
        __syncthreads();
        { const int c = tid >> 1, t0 = (tid & 1) * (NTOK / 2); bf16* dst = VT2 + ((size_t)(chunk * 4096 + g * 256 + c) * 128 + toff + t0);
#pragma unroll
          for (int q = 0; q < NTOK / 16; ++q) { u32x4 o; const bf16* sp = T + (t0 + 8 * q) * 264 + c;
              o.x = (unsigned)sp[0] | ((unsigned)sp[264] << 16); o.y = (unsigned)sp[2 * 264] | ((unsigned)sp[3 * 264] << 16); o.z = (unsigned)sp[4 * 264] | ((unsigned)sp[5 * 264] << 16); o.w = (unsigned)sp[6 * 264] | ((unsigned)sp[7 * 264] << 16);
              *(u32x4*)(dst + 8 * q) = o; } }
        __syncthreads();
#pragma unroll
        for (int i = 0; i < NTOK / 16; ++i) wv[i] = wn[i];
    }
}
__device__ __forceinline__ void phase_gmlp_ln(const Params& p, unsigned char* lds) {
    for (int item = blockIdx.x; item < 256 + 32; item += gridDim.x) {
        if (item < 256) gmlp_ln_item<64>(p, lds, item >> 1, (item & 1) * 64);
        else { const int i2 = item - 256; gmlp_ln_item<16>(p, lds, 128 + (i2 >> 3), (i2 & 7) * 16); }
    }
}
struct EpiGmlpS {
    static constexpr bool PERM = true;
    unsigned char* ws; const float* bs;
    __device__ __forceinline__ void operator()(const pg8::f32x4 (&acc)[2][2][4][2], const Unit& u, int wr, int wc, int fr, int fq) const {
        { int t_ = tidx(); fr = t_ & 15; fq = (t_ >> 4) & 3; }
        bf16* const UG = (bf16*)(ws + WS_UG); const bf16* const ZG = (const bf16*)(ws + WS_ZG);
        u32x4 uv[4][2], zv[4][2]; float bias[4];
#pragma unroll
        for (int m = 0; m < 4; ++m) { const int sl = wr * 64 + m * 16 + fr; bias[m] = bs[u.pn * 128 + sl];
#pragma unroll
            for (int bj = 0; bj < 2; ++bj) { const size_t off = (size_t)(u.pm * 128 + sl) * 4096 + u.pn * 256 + bj * 128 + wc * 32 + 8 * fq; uv[m][bj] = *(const u32x4*)(UG + off); zv[m][bj] = *(const u32x4*)(ZG + off); } }
#pragma unroll
        for (int m = 0; m < 4; ++m) { const int sl = wr * 64 + m * 16 + fr;
#pragma unroll
            for (int bj = 0; bj < 2; ++bj) { const size_t off = (size_t)(u.pm * 128 + sl) * 4096 + u.pn * 256 + bj * 128 + wc * 32 + 8 * fq;
                const u32x4 uu = uv[m][bj], zz = zv[m][bj]; pg8::f32x4 a = acc[0][bj][m][0] + bias[m], b = acc[0][bj][m][1] + bias[m];
                a[0] *= __uint_as_float(uu.x << 16) * __uint_as_float(zz.x << 16); a[1] *= __uint_as_float(uu.x & 0xffff0000u) * __uint_as_float(zz.x & 0xffff0000u);
                a[2] *= __uint_as_float(uu.y << 16) * __uint_as_float(zz.y << 16); a[3] *= __uint_as_float(uu.y & 0xffff0000u) * __uint_as_float(zz.y & 0xffff0000u);
                b[0] *= __uint_as_float(uu.z << 16) * __uint_as_float(zz.z << 16); b[1] *= __uint_as_float(uu.z & 0xffff0000u) * __uint_as_float(zz.z & 0xffff0000u);
                b[2] *= __uint_as_float(uu.w << 16) * __uint_as_float(zz.w << 16); b[3] *= __uint_as_float(uu.w & 0xffff0000u) * __uint_as_float(zz.w & 0xffff0000u);
                *(u32x4*)(UG + off) = pack8(a, b); } }
    }
};
__device__ __forceinline__ void phase_gmlp_spatial(const Params& p, unsigned char* lds) {
    pg8::Gemm g{128, 128, 128};
    SchedLin S; S.init(132 * 256, 4096, gridDim.x, blockIdx.x); S.A0 = (const char*)(p.ws + WS_WSB); S.sAm = 0; S.sAn = 128 * 128 * 2; S.B0 = (const char*)(p.ws + WS_VT2); S.sBm = (size_t)4096 * 128 * 2; S.sBn = 256 * 128 * 2;
    EpiGmlpS E{p.ws, p.in[14]};
    pg8::gemm_phase<EpiGmlpS, SchedLin, true>((PG8_LAS unsigned char*)lds, g, S, E);
}

__device__ __forceinline__ void phase_final(const Params& p) {
    const int lane = tidx() & 63, gw = blockIdx.x * NWAVES + (tidx() >> 6), NGW = gridDim.x * NWAVES;
    const float* gvec = p.in[17];
    f32x4 x[8], xn[8];
    int row = gw;
    if (row < ML) {
#pragma unroll
        for (int j = 0; j < 8; ++j) x[j] = *(const f32x4*)(p.out + (size_t)row * DM + 4 * lane + 256 * j); }
    for (; row < ML; row += NGW) {
        const int rn = row + NGW;
        if (rn < ML) {
#pragma unroll
            for (int j = 0; j < 8; ++j) xn[j] = *(const f32x4*)(p.out + (size_t)rn * DM + 4 * lane + 256 * j); }
        float* xr = p.out + (size_t)row * DM; float s = 0.f;
#pragma unroll
        for (int j = 0; j < 8; ++j) s += (x[j].x * x[j].x + x[j].y * x[j].y) + (x[j].z * x[j].z + x[j].w * x[j].w);
        const float rstd = rsqrtf(wave_sum(s) * (1.f / DM) + EPS);
#pragma unroll
        for (int j = 0; j < 8; ++j) { const int c0 = 4 * lane + 256 * j; const f32x4 g4 = *(const f32x4*)(gvec + c0); *(f32x4*)(xr + c0) = x[j] * rstd * g4; }
#pragma unroll
        for (int j = 0; j < 8; ++j) x[j] = xn[j];
    }
}

#define XB_TMO      128
#define XB_XCNT(j)  (256  + 64 * (j))
#define XB_XSUB(j)  (1280 + 64 * (j))
#define XB_XGEN(j)  (2304 + 64 * (j))
#define XB_TOP      3328
#define XB_TOPGEN   3392
#define XCD_BAR_WORDS 3456
#define XB_SPIN_CAP (1u << 22)
__device__ __forceinline__ unsigned xb_ld(unsigned* p)              { return __hip_atomic_load(p, __ATOMIC_RELAXED, __HIP_MEMORY_SCOPE_AGENT); }
__device__ __forceinline__ unsigned xb_add(unsigned* p, unsigned v) { return __hip_atomic_fetch_add(p, v, __ATOMIC_RELAXED, __HIP_MEMORY_SCOPE_AGENT); }
__device__ __forceinline__ unsigned xb_xcc_id() { return (unsigned)__builtin_amdgcn_s_getreg((3 << 11) | 20) & 0xFu; }
#define XB_SPIN(cond, bar) do { unsigned _sp = 0; while (cond) { \
    if ((++_sp & 255u) == 0u) { if (xb_ld(&(bar)[XB_TMO])) break; if (_sp > XB_SPIN_CAP) { atomicAdd(&(bar)[XB_TMO], 1u); break; } } } } while (0)
struct XcdBarrier { unsigned* bar; unsigned x; volatile __attribute__((address_space(3))) unsigned* st; };
__device__ __forceinline__ XcdBarrier xcd_barrier_post(unsigned* bar, volatile __attribute__((address_space(3))) unsigned* st) {
    XcdBarrier b; b.bar = bar; b.x = xb_xcc_id(); b.st = st;
    if (threadIdx.x == 0) (void)xb_add(&bar[XB_XCNT(b.x)], 1u);
    return b;
}
__device__ __forceinline__ void xcd_barrier_complete(unsigned* bar, unsigned x, unsigned& nloc, unsigned& nx) {
    const unsigned G = gridDim.x * gridDim.y * gridDim.z;
    unsigned sum, cnt, mine, sp = 0u;
    for (;;) {
        sum = 0u; cnt = 0u; mine = 0u;
#pragma unroll
        for (unsigned j = 0; j < 16; ++j) { const unsigned c = xb_ld(&bar[XB_XCNT(j)]); sum += c; cnt += (c > 0u) ? 1u : 0u; mine = (j == x) ? c : mine; }
        if (sum == G) break;
        __builtin_amdgcn_s_sleep(1);
        if ((++sp & 255u) == 0u) { if (xb_ld(&bar[XB_TMO])) break; if (sp > XB_SPIN_CAP) { atomicAdd(&bar[XB_TMO], 1u); break; } }
    }
    nloc = mine > 0u ? mine : 1u; nx = cnt > 0u ? cnt : 1u;
}
__device__ __forceinline__ void xcd_barrier(const XcdBarrier& b) {
    asm volatile("s_waitcnt vmcnt(0)" ::: "memory");
    __syncthreads();
    if (threadIdx.x == 0) {
        unsigned* bar = b.bar;
        __builtin_amdgcn_s_waitcnt(0);
        unsigned nloc = b.st[0], nx = b.st[1];
        if (nloc == 0u) { xcd_barrier_complete(bar, b.x, nloc, nx); b.st[0] = nloc; b.st[1] = nx; }
        const unsigned old = xb_add(&bar[XB_XSUB(b.x)], 1u);
        const unsigned gen = old / nloc;
        if (old + 1u == (gen + 1u) * nloc) {
            __builtin_amdgcn_fence(__ATOMIC_RELEASE, "agent");
            asm volatile("s_waitcnt vmcnt(0)" ::: "memory");
            const unsigned og = xb_add(&bar[XB_TOP], 1u);
            const unsigned tg = og / nx;
            if (og + 1u == (tg + 1u) * nx) xb_add(&bar[XB_TOPGEN], 1u);
            else XB_SPIN(xb_ld(&bar[XB_TOPGEN]) == tg, bar);
            __builtin_amdgcn_fence(__ATOMIC_ACQUIRE, "agent");
            xb_add(&bar[XB_XGEN(b.x)], 1u);
            asm volatile("s_waitcnt vmcnt(0)" ::: "memory");
        } else {
            XB_SPIN(xb_ld(&bar[XB_XGEN(b.x)]) == gen, bar);
            __builtin_amdgcn_fence(__ATOMIC_ACQUIRE, "agent");
            asm volatile("s_waitcnt vmcnt(0)" ::: "memory");
        }
    }
    __syncthreads();
}

constexpr int NPH = 23;
__global__ void __launch_bounds__(NTHR, 2) fwd(Params p) {
    extern __shared__ __attribute__((aligned(16))) unsigned char lds[];
    cg::grid_group grid = cg::this_grid();
    const int lo = p.ph_lo, hi = p.ph_hi;
    volatile __attribute__((address_space(3))) unsigned* bst = (volatile __attribute__((address_space(3))) unsigned*)((__attribute__((address_space(3))) unsigned char*)lds + 131072 + 2048);
    if (threadIdx.x < 2) bst[threadIdx.x] = 0u;
    __syncthreads();
    const XcdBarrier xbar = xcd_barrier_post((unsigned*)(p.ws + WS_BAR), bst);
    if (hi > 1000) grid.sync();
#define PHASE(k, ...) if (lo <= (k) && (k) < hi) { __VA_ARGS__; if ((k) + 1 < hi) xcd_barrier(xbar); }
    PHASE(0, phase0(p, lds))
    PHASE(1, phase_prep<0>(p, lds))
    PHASE(2, phase_inproj_fnet<0>(p, lds))
    PHASE(3, phase_fnet_a(p, true, lds))
    PHASE(4, phase_fnet_c(p, lds))
    PHASE(5, phase_fnet_mix<0>(p, lds))
    PHASE(6, phase_outproj<0>(p, lds))
    PHASE(7, phase_prep<1>(p, lds))
    PHASE(8, phase_inproj_attn(p, lds))
    PHASE(9, phase_attn(p, lds))
    PHASE(10, phase_outproj<1>(p, lds))
    PHASE(11, phase_prep<2>(p, lds))
    PHASE(12, phase_inproj_gmlp(p, lds))
    PHASE(13, phase_gmlp_ln(p, lds))
    PHASE(14, phase_gmlp_spatial(p, lds))
    PHASE(15, phase_outproj<2>(p, lds))
    PHASE(16, phase_prep<3>(p, lds))
    PHASE(17, phase_inproj_fnet<3>(p, lds))
    PHASE(18, phase_fnet_a(p, false, lds))
    PHASE(19, phase_fnet_c(p, lds))
    PHASE(20, phase_fnet_mix<3>(p, lds))
    PHASE(21, phase_outproj<3>(p, lds))
    PHASE(22, phase_final(p))
#undef PHASE
}

extern "C" void kernel_launch(void* const* d_in, const int* in_sizes, int n_in, void* d_out, int out_size, void* d_ws, size_t ws_size, hipStream_t stream) {
    static int grid = 0;
    if (grid == 0) {
        int dev = 0, cus = 0, per_cu = 0;
        (void)hipGetDevice(&dev); (void)hipDeviceGetAttribute(&cus, hipDeviceAttributeMultiprocessorCount, dev);
        (void)hipFuncSetAttribute((const void*)fwd, hipFuncAttributeMaxDynamicSharedMemorySize, LDS_BYTES);
        (void)hipOccupancyMaxActiveBlocksPerMultiprocessor(&per_cu, (const void*)fwd, NTHR, LDS_BYTES);
        if (per_cu < 1) { fprintf(stderr, "kernel_launch: occupancy query says %d blocks per CU\n", per_cu); per_cu = 1; }
        (void)hipGetLastError();
        grid = cus;
        if (n_in != 18 || ws_size < WS_END) fprintf(stderr, "kernel_launch: unexpected n_in %d / ws_size %zu\n", n_in, ws_size);
    }
    (void)hipMemsetAsync((char*)d_ws + WS_BAR, 0, XCD_BAR_WORDS * 4, stream);
    Params p{};
    for (int i = 0; i < 18; ++i) p.in[i] = (const float*)d_in[i];
    p.out = (float*)d_out; p.ws = (unsigned char*)d_ws;
#if MK_COOP
    p.ph_lo = 0; p.ph_hi = NPH;
    void* args[] = {&p};
    hipError_t e = hipLaunchCooperativeKernel((const void*)fwd, dim3(grid), dim3(NTHR), args, LDS_BYTES, stream);
    if (e != hipSuccess) fprintf(stderr, "cooperative launch failed: %s (grid %d)\n", hipGetErrorString(e), grid);
#else
    for (int ph = 0; ph < NPH; ++ph) { p.ph_lo = ph; p.ph_hi = ph + 1; hipLaunchKernelGGL(fwd, dim3(grid), dim3(NTHR), LDS_BYTES, stream, p); }
#endif
}
```
